# Optimizing an MI355X kernel written in HIP

```python
import math
import jax, jax.numpy as jnp
from jax import lax
import numpy as np

D_MODEL = 2048
BATCH = 4
SEQ = 4096
DEPTH = 1

HEAD_DIM = 128
MIX_WIDTH = D_MODEL
DIFF_WIDTH = MIX_WIDTH // 4
DIL_WIDTH = MIX_WIDTH - DIFF_WIDTH
N_DIL_HEADS = DIL_WIDTH // HEAD_DIM
DIL_CONFIGS = ((128, 1), (512, 4), (2048, 16))
DIL_BLOCK = 64
DIFF_QK_DIM = 64
DIFF_V_DIM = 2 * DIFF_QK_DIM
N_DIFF_HEADS = DIFF_WIDTH // DIFF_V_DIM
DIFF_QK_WIDTH = N_DIFF_HEADS * 2 * DIFF_QK_DIM
IN_WIDTH = 3 * DIL_WIDTH + 2 * DIFF_QK_WIDTH + DIFF_WIDTH
Q_BLOCK = 128
ROPE_THETA = 500000.0
ROPE_FRACTION = 4
PEER_HEADS = 8
PEER_N_KEYS = 128
PEER_N_EXPERTS = PEER_N_KEYS * PEER_N_KEYS
PEER_KEY_DIM = 256
PEER_TOPK = 16
PEER_TOKEN_BLOCK = 64
LN_EPS = 1e-5
NEG_BIG = -1e30
DEEPNORM_ALPHA = (2.0 * DEPTH) ** 0.25
DEEPNORM_BETA = (8.0 * DEPTH) ** -0.25

kernel_name = "hybrid_dilated_diffattn_peer_encoder_layer"


def layer_norm(x, g, b):
    xf = x.astype(jnp.float32)
    mu = jnp.mean(xf, -1, keepdims=True)
    xc = xf - mu
    var = jnp.mean(xc * xc, -1, keepdims=True)
    return (xc * lax.rsqrt(var + LN_EPS) * g.astype(jnp.float32) + b.astype(jnp.float32)).astype(x.dtype)


def head_rms(t, g):
    return t * lax.rsqrt(jnp.mean(t * t, -1, keepdims=True) + LN_EPS) * g.astype(jnp.float32)


def rope_tables(seq, rot_dim):
    inv_freq = 1.0 / (ROPE_THETA ** (jnp.arange(0, rot_dim, 2, dtype=jnp.float32) / rot_dim))
    ang = jnp.arange(seq, dtype=jnp.float32)[:, None] * inv_freq[None, :]
    return jnp.cos(ang), jnp.sin(ang)


def partial_rope(t, cos, sin):
    half = cos.shape[-1]
    shp = (1, t.shape[1]) + (1,) * (t.ndim - 3) + (half,)
    c = cos.reshape(shp).astype(t.dtype)
    s = sin.reshape(shp).astype(t.dtype)
    t1 = t[..., :half]
    t2 = t[..., half:2 * half]
    return jnp.concatenate([t1 * c - t2 * s, t1 * s + t2 * c, t[..., 2 * half:]], axis=-1)


def dilated_window_attention(q, k, v, window, dilation):
    B, S, H, dh = q.shape
    L = S // dilation
    half = window // (2 * dilation)
    blk = DIL_BLOCK
    nb = -(-L // blk)
    Lp = nb * blk

    def strided(t):
        t = t.reshape(B, L, dilation, H, dh).transpose(0, 2, 1, 3, 4)
        return jnp.pad(t, ((0, 0), (0, 0), (0, Lp - L), (0, 0), (0, 0)))

    def neighbours(t):
        tp = jnp.pad(t, ((0, 0), (0, 0), (blk, blk), (0, 0), (0, 0))).reshape(B, dilation, nb + 2, blk, H, dh)
        return jnp.concatenate([tp[:, :, :-2], tp[:, :, 1:-1], tp[:, :, 2:]], axis=3)

    qb = strided(q).reshape(B, dilation, nb, blk, H, dh)
    kn = neighbours(strided(k))
    vn = neighbours(strided(v)).astype(jnp.float32)
    s = jnp.einsum('brnqhd,brnkhd->brnhqk', qb, kn).astype(jnp.float32) * (dh ** -0.5)
    qi = jnp.arange(blk)[:, None]
    kj = jnp.arange(3 * blk)[None, :]
    kpos = (jnp.arange(nb)[:, None, None] - 1) * blk + kj[None]
    mask = (jnp.abs(blk + qi - kj) <= half)[None] & (kpos >= 0) & (kpos < L)
    s = jnp.where(mask[None, None, :, None], s, NEG_BIG)
    m = jnp.max(s, -1, keepdims=True)
    p = jnp.exp(s - m)
    den = jnp.sum(p, -1)
    o = jnp.einsum('brnhqk,brnkhd->brnqhd', p, vn) / jnp.swapaxes(den, -1, -2)[..., None]
    lse = jnp.swapaxes(m[..., 0] + jnp.log(den), -1, -2)

    def unstride(t):
        t = t.reshape((B, dilation, Lp) + t.shape[4:])[:, :, :L]
        t = jnp.moveaxis(t, 1, 2)
        return t.reshape((B, S) + t.shape[3:])

    return unstride(o), unstride(lse)


def differential_attention(q, k, v, lam):
    B, S, H, _, dq = q.shape
    nqb = S // Q_BLOCK
    qb = jnp.moveaxis(q.reshape(B, nqb, Q_BLOCK, H, 2, dq), 1, 0)
    vf = v.astype(jnp.float32)
    scale = dq ** -0.5

    def one_block(qblk):
        s = jnp.einsum('bqhmd,bkhmd->bhmqk', qblk, k).astype(jnp.float32) * scale
        p = jax.nn.softmax(s, axis=-1)
        a = p[:, :, 0] - lam * p[:, :, 1]
        return jnp.einsum('bhqk,bkhd->bqhd', a, vf)

    o = lax.map(one_block, qb)
    return jnp.moveaxis(o, 0, 1).reshape(B, S, H, v.shape[-1])


def hybrid_mixer(h, w_in, dil_norm_g, lambda_q1, lambda_k1, lambda_q2, lambda_k2, subln_g, w_out,
                 lam_init, rope_dil, rope_diff):
    B, S, _ = h.shape
    proj = jnp.einsum('bsd,de->bse', h, w_in)
    splits = [DIL_WIDTH, 2 * DIL_WIDTH, 3 * DIL_WIDTH,
              3 * DIL_WIDTH + DIFF_QK_WIDTH, 3 * DIL_WIDTH + 2 * DIFF_QK_WIDTH]
    qa, ka, va, qd, kd, vd = jnp.split(proj, splits, axis=-1)

    qa = partial_rope(qa.reshape(B, S, N_DIL_HEADS, HEAD_DIM), *rope_dil)
    ka = partial_rope(ka.reshape(B, S, N_DIL_HEADS, HEAD_DIM), *rope_dil)
    va = va.reshape(B, S, N_DIL_HEADS, HEAD_DIM)
    outs, lses = [], []
    for window, dilation in DIL_CONFIGS:
        o, l = dilated_window_attention(qa, ka, va, window, dilation)
        outs.append(o)
        lses.append(l)
    wts = jax.nn.softmax(jnp.stack(lses), axis=0)
    dil_out = jnp.sum(wts[..., None] * jnp.stack(outs), axis=0)
    dil_out = head_rms(dil_out, dil_norm_g).reshape(B, S, DIL_WIDTH)

    qd = partial_rope(qd.reshape(B, S, N_DIFF_HEADS, 2, DIFF_QK_DIM), *rope_diff)
    kd = partial_rope(kd.reshape(B, S, N_DIFF_HEADS, 2, DIFF_QK_DIM), *rope_diff)
    vd = vd.reshape(B, S, N_DIFF_HEADS, DIFF_V_DIM)
    lam = (jnp.exp(jnp.sum(lambda_q1.astype(jnp.float32) * lambda_k1.astype(jnp.float32)))
           - jnp.exp(jnp.sum(lambda_q2.astype(jnp.float32) * lambda_k2.astype(jnp.float32)))
           + lam_init)
    od = differential_attention(qd, kd, vd, lam)
    od = head_rms(od, subln_g) * (1.0 - lam_init)

    mixed = jnp.concatenate([dil_out, od.reshape(B, S, DIFF_WIDTH)], axis=-1).astype(h.dtype)
    return jnp.einsum('bse,ed->bsd', mixed, w_out)


def peer_ffn(h, w_query, sub_keys, expert_u, expert_v):
    B, S, D = h.shape
    T = B * S
    xt = h.reshape(T, D)
    q = jnp.einsum('td,de->te', xt, w_query).reshape(T, PEER_HEADS, 2, PEER_KEY_DIM // 2)
    s = jnp.einsum('thcd,hcnd->thcn', q, sub_keys).astype(jnp.float32)
    sv, si = lax.top_k(s, PEER_TOPK)
    cand = (sv[:, :, 0, :, None] + sv[:, :, 1, None, :]).reshape(T, PEER_HEADS, PEER_TOPK * PEER_TOPK)
    cand_idx = (si[:, :, 0, :, None] * PEER_N_KEYS + si[:, :, 1, None, :]).reshape(T, PEER_HEADS, PEER_TOPK * PEER_TOPK)
    top_s, pos = lax.top_k(cand, PEER_TOPK)
    idx = jnp.take_along_axis(cand_idx, pos, axis=-1)
    g = jax.nn.softmax(top_s, axis=-1)

    nblk = T // PEER_TOKEN_BLOCK
    xs = xt.reshape(nblk, PEER_TOKEN_BLOCK, D)
    idxs = idx.reshape(nblk, PEER_TOKEN_BLOCK, PEER_HEADS * PEER_TOPK)
    gs = g.reshape(nblk, PEER_TOKEN_BLOCK, PEER_HEADS * PEER_TOPK)

    def block(args):
        xb, ib, gb = args
        u = expert_u[ib]
        a = gb.astype(xb.dtype) * jax.nn.gelu(jnp.einsum('tkd,td->tk', u, xb), approximate=False)
        return jnp.einsum('tk,tkd->td', a, expert_v[ib])

    y = lax.map(block, (xs, idxs, gs))
    return y.reshape(B, S, D)


def setup_inputs(seed: int = 0) -> dict:
    key = jax.random.key(seed)
    ks = jax.random.split(key, 20)
    f32 = jnp.float32

    def nrm(k, shape, scale):
        return jax.random.normal(k, shape, f32) * scale

    col_scale = jnp.concatenate([
        jnp.ones((2 * DIL_WIDTH,), f32), jnp.full((DIL_WIDTH,), DEEPNORM_BETA, f32),
        jnp.ones((2 * DIFF_QK_WIDTH,), f32), jnp.full((DIFF_WIDTH,), DEEPNORM_BETA, f32)])
    return {
        "x": nrm(ks[0], (BATCH, SEQ, D_MODEL), 1.0),
        "ln_emb_g": 1.0 + nrm(ks[1], (D_MODEL,), 0.02),
        "ln_emb_b": nrm(ks[2], (D_MODEL,), 0.02),
        "w_in": nrm(ks[3], (DEPTH, D_MODEL, IN_WIDTH), D_MODEL ** -0.5) * col_scale,
        "dil_norm_g": 1.0 + nrm(ks[4], (DEPTH, HEAD_DIM), 0.02),
        "lambda_q1": nrm(ks[5], (DEPTH, DIFF_QK_DIM), 0.1),
        "lambda_k1": nrm(ks[6], (DEPTH, DIFF_QK_DIM), 0.1),
        "lambda_q2": nrm(ks[7], (DEPTH, DIFF_QK_DIM), 0.1),
        "lambda_k2": nrm(ks[8], (DEPTH, DIFF_QK_DIM), 0.1),
        "subln_g": 1.0 + nrm(ks[9], (DEPTH, DIFF_V_DIM), 0.02),
        "w_out": nrm(ks[10], (DEPTH, MIX_WIDTH, D_MODEL), MIX_WIDTH ** -0.5 * DEEPNORM_BETA),
        "ln1_g": 1.0 + nrm(ks[11], (DEPTH, D_MODEL), 0.02),
        "ln1_b": nrm(ks[12], (DEPTH, D_MODEL), 0.02),
        "peer_w_query": nrm(ks[13], (DEPTH, D_MODEL, PEER_HEADS * PEER_KEY_DIM), D_MODEL ** -0.5),
        "peer_sub_keys": nrm(ks[14], (DEPTH, PEER_HEADS, 2, PEER_N_KEYS, PEER_KEY_DIM // 2), (PEER_KEY_DIM // 2) ** -0.5),
        "peer_u": nrm(ks[15], (DEPTH, PEER_N_EXPERTS, D_MODEL), D_MODEL ** -0.5),
        "peer_v": nrm(ks[16], (DEPTH, PEER_N_EXPERTS, D_MODEL), DEEPNORM_BETA),
        "ln2_g": 1.0 + nrm(ks[17], (DEPTH, D_MODEL), 0.02),
        "ln2_b": nrm(ks[18], (DEPTH, D_MODEL), 0.02),
    }


def reference(x, ln_emb_g, ln_emb_b, w_in, dil_norm_g, lambda_q1, lambda_k1, lambda_q2, lambda_k2,
              subln_g, w_out, ln1_g, ln1_b, peer_w_query, peer_sub_keys, peer_u, peer_v, ln2_g, ln2_b):
    S = x.shape[1]
    rope_dil = rope_tables(S, HEAD_DIM // ROPE_FRACTION)
    rope_diff = rope_tables(S, DIFF_QK_DIM // ROPE_FRACTION)
    h = layer_norm(x, ln_emb_g, ln_emb_b)
    for l in range(DEPTH):
        lam_init = 0.8 - 0.6 * math.exp(-0.3 * l)
        mix = hybrid_mixer(h, w_in[l], dil_norm_g[l], lambda_q1[l], lambda_k1[l], lambda_q2[l], lambda_k2[l],
                           subln_g[l], w_out[l], lam_init, rope_dil, rope_diff)
        h = layer_norm(DEEPNORM_ALPHA * h + mix, ln1_g[l], ln1_b[l])
        ffn = peer_ffn(h, peer_w_query[l], peer_sub_keys[l], peer_u[l], peer_v[l])
        h = layer_norm(DEEPNORM_ALPHA * h + ffn, ln2_g[l], ln2_b[l])
    return h
```

```cpp
#include <hip/hip_runtime.h>
#include <hip/hip_bf16.h>
#include <cstdio>
#include <cstdint>
#include <cmath>

#ifndef MK_N_LAUNCHES
#define MK_N_LAUNCHES 9
#endif
#ifndef DBG_MODE
#define DBG_MODE 0
#endif
#ifndef MK_PHASE_HI
#define MK_PHASE_HI 9
#endif

namespace pg8 {
#define PG8_LAS __attribute__((address_space(3)))
typedef unsigned short bf16_t;
typedef short bf16x8 __attribute__((ext_vector_type(8)));
typedef float f32x4 __attribute__((ext_vector_type(4)));
typedef unsigned u32x4 __attribute__((ext_vector_type(4)));
constexpr int BM = 256, BK = 64, HALF = 128, HTB = HALF * BK * 2  , STAGE_BYTES = 8 * HTB, NXCD = 8, WGM = 8;

__host__ __device__ __forceinline__ int lds_byte(int r, int c) { const int st = (r >> 4) * 2 + (c >> 5), rr = r & 15, cc = c & 31, ob = rr * 64 + cc * 2; return st * 1024 + (ob ^ (((ob >> 9) & 1) << 5)); }
__host__ __device__ __forceinline__ void stage_rc(int b, int& R, int& C) { const int st = b / 1024, sb = b % 1024, swz = sb ^ (((sb >> 9) & 1) << 5); R = (st >> 1) * 16 + swz / 64; C = (st & 1) * 32 + (swz % 64) / 2; }
__host__ __device__ __forceinline__ int perm32(int rho) { const int n = rho >> 4, i = rho & 15; return 8 * (i >> 2) + 4 * n + (i & 3); }

struct Unit { int pm, pn; };
struct Gemm { const bf16_t* A; const bf16_t* Bt; int M, N, K; };

struct StaticOrder {
    int nM, nN, nwg, G, c;
    __host__ __device__ void init(int M, int N, int G_, int c_) { nM = M / BM; nN = N / BM; nwg = nM * nN; G = G_; c = c_; }
    __host__ __device__ bool next(int i, Unit& u) const {
        const long L = (long)i * G + c; if (L >= nwg) return false;
        int wgid = (int)L; { const int q = nwg / NXCD, r = nwg % NXCD, xcd = wgid % NXCD, off = wgid / NXCD; wgid = (xcd < r ? xcd * (q + 1) : r * (q + 1) + (xcd - r) * q) + off; }
        const int nig = WGM * nN, gid = wgid / nig, fm = gid * WGM, gsz = (nM - fm) < WGM ? (nM - fm) : WGM;
        u.pm = fm + ((wgid % nig) % gsz); u.pn = (wgid % nig) / gsz; return true;
    }
    __device__ __forceinline__ void a_ready(const Unit&) const {}
    __device__ __forceinline__ void done(const Unit&) const {}
};

__device__ __forceinline__ unsigned cvt_pk_bf16(float lo, float hi) { unsigned r; asm volatile("v_cvt_pk_bf16_f32 %0, %1, %2" : "=v"(r) : "v"(lo), "v"(hi)); return r; }

template <int ACT  > struct EpiBf16 {
    static constexpr bool PERM = true, AFTER_DRAIN = false; static_assert(ACT == 0 || ACT == 1, "EpiBf16: ACT is 0 (none) or 1 (gelu_pk)");
    bf16_t* O; int ldc; const float* bias; int split_cols; size_t split_stride; float scale0;
    __device__ __forceinline__ void operator()(const f32x4 (&acc)[2][2][4][2], const Unit& u, int wr, int wc, int fr, int fq) const {
        const int row0 = u.pm * BM + wr * 64 + fr; int colt = u.pn * BM; bf16_t* base = O;
        float sc = 1.f; if (split_cols) { const int t = colt / split_cols; base += (size_t)t * split_stride; colt -= t * split_cols; if (t == 0) sc = scale0; }
        const int col0 = colt + wc * 32 + 8 * fq, bcol0 = u.pn * BM + wc * 32 + 8 * fq;
        f32x4 bv[2][2];
#pragma unroll
        for (int bj = 0; bj < 2; ++bj)
#pragma unroll
            for (int n = 0; n < 2; ++n) bv[bj][n] = bias ? *(const f32x4*)(bias + bcol0 + bj * HALF + 4 * n) : (f32x4){0.f, 0.f, 0.f, 0.f};
#pragma unroll
        for (int ai = 0; ai < 2; ++ai)
#pragma unroll
            for (int m = 0; m < 4; ++m) { bf16_t* rowp = base + (size_t)(row0 + ai * HALF + m * 16) * ldc + col0;
#pragma unroll
                for (int bj = 0; bj < 2; ++bj) { f32x4 v0 = acc[ai][bj][m][0] + bv[bj][0], v1 = acc[ai][bj][m][1] + bv[bj][1];
                    v0 = v0 * sc; v1 = v1 * sc; u32x4 w; w.x = cvt_pk_bf16(v0[0], v0[1]); w.y = cvt_pk_bf16(v0[2], v0[3]); w.z = cvt_pk_bf16(v1[0], v1[1]); w.w = cvt_pk_bf16(v1[2], v1[3]);
                    *(u32x4*)(rowp + bj * HALF) = w; } }
    }
};

__device__ __forceinline__ f32x4 shx4(f32x4 v, int mask) { f32x4 r; r[0] = __shfl_xor(v[0], mask); r[1] = __shfl_xor(v[1], mask); r[2] = __shfl_xor(v[2], mask); r[3] = __shfl_xor(v[3], mask); return r; }
struct EpiQKV {
    static constexpr bool PERM = true, AFTER_DRAIN = false;
    bf16_t *QA, *KA, *VA, *QD, *KD, *VD;
    const float* ropeA;
    const float* ropeD;
    float qd_scale;
    __device__ __forceinline__ void operator()(const f32x4 (&acc)[2][2][4][2], const Unit& u, int wr, int wc, int fr, int fq) const {
        const int pn = u.pn;
        bf16_t* base; int ldc, colt, kind; float sc = 1.f;
        if (pn < 6)       { base = QA; ldc = 1536; colt = pn * 256;        kind = 1; }
        else if (pn < 12) { base = KA; ldc = 1536; colt = (pn - 6) * 256;  kind = 1; }
        else if (pn < 18) { base = VA; ldc = 1536; colt = (pn - 12) * 256; kind = 0; }
        else if (pn < 20) { base = QD; ldc = 512;  colt = (pn - 18) * 256; kind = 2; sc = qd_scale; }
        else if (pn < 22) { base = KD; ldc = 512;  colt = (pn - 20) * 256; kind = 2; }
        else              { base = VD; ldc = 512;  colt = (pn - 22) * 256; kind = 0; }
        const int row0 = u.pm * BM + wr * 64 + fr, col0 = colt + wc * 32 + 8 * fq;
        const bool ra = (kind == 1) && (wc == 0);
        const bool rd = (kind == 2) && ((wc & 1) == 0);
#pragma unroll
        for (int ai = 0; ai < 2; ++ai)
#pragma unroll
            for (int m = 0; m < 4; ++m) {
                const int row = row0 + ai * HALF + m * 16, pos = row & 4095;
                f32x4 c0 = {1.f, 1.f, 1.f, 1.f}, c1 = c0, s0 = {0.f, 0.f, 0.f, 0.f}, s1 = s0;
                if (ra) { const float* t = ropeA + pos * 32 + 8 * (fq & 1); c0 = *(const f32x4*)t; c1 = *(const f32x4*)(t + 4); s0 = *(const f32x4*)(t + 16); s1 = *(const f32x4*)(t + 20);
                          if (fq < 2) { s0 = -s0; s1 = -s1; } }
                if (rd) { if (fq < 2) { const float* t = ropeD + pos * 16; c0 = *(const f32x4*)t; c1 = *(const f32x4*)(t + 4); s0 = *(const f32x4*)(t + 8); s1 = *(const f32x4*)(t + 12);
                          if (fq == 0) { s0 = -s0; s1 = -s1; } } }
                bf16_t* rowp = base + (size_t)row * ldc + col0;
#pragma unroll
                for (int bj = 0; bj < 2; ++bj) {
                    f32x4 v0 = acc[ai][bj][m][0], v1 = acc[ai][bj][m][1];
                    if (ra) { const f32x4 p0 = shx4(v0, 32), p1 = shx4(v1, 32); v0 = v0 * c0 + p0 * s0; v1 = v1 * c1 + p1 * s1; }
                    if (rd) { const f32x4 p0 = shx4(v0, 16), p1 = shx4(v1, 16); v0 = v0 * c0 + p0 * s0; v1 = v1 * c1 + p1 * s1; }
                    v0 = v0 * sc; v1 = v1 * sc;
                    u32x4 w; w.x = cvt_pk_bf16(v0[0], v0[1]); w.y = cvt_pk_bf16(v0[2], v0[3]); w.z = cvt_pk_bf16(v1[0], v1[1]); w.w = cvt_pk_bf16(v1[2], v1[3]);
                    *(u32x4*)(rowp + bj * HALF) = w; }
            }
    }
};
struct EpiPre {
    static constexpr bool PERM = false, AFTER_DRAIN = false;
    const bf16_t* H0; float* PRE; float alpha;
    __device__ __forceinline__ void operator()(const f32x4 (&acc)[2][2][4][2], const Unit& u, int wr, int wc, int fr, int fq) const {
        const int row0 = u.pm * BM + wr * 64 + fr, col0 = u.pn * BM + wc * 32 + 4 * fq;
#pragma unroll
        for (int ai = 0; ai < 2; ++ai)
#pragma unroll
            for (int m = 0; m < 4; ++m) { const size_t off = (size_t)(row0 + ai * HALF + m * 16) * 2048 + col0;
#pragma unroll
                for (int bj = 0; bj < 2; ++bj)
#pragma unroll
                    for (int n = 0; n < 2; ++n) { const size_t o = off + bj * HALF + n * 16;
                        const uint2 h = *(const uint2*)(H0 + o);
                        const f32x4 hv = {__uint_as_float(h.x << 16), __uint_as_float(h.x & 0xffff0000u), __uint_as_float(h.y << 16), __uint_as_float(h.y & 0xffff0000u)};
                        *(f32x4*)(PRE + o) = hv * alpha + acc[ai][bj][m][n] * (DBG_MODE == 2 ? 0.f : 1.f); } }
    }
};

template <class Epi, class Sched, bool ALIGN_EPI = false, bool SP2 = false>
__device__ __forceinline__ void gemm_phase(PG8_LAS unsigned char* lds, const Gemm g, const Sched& S, const Epi& E) {
    const int tid = threadIdx.x, wid = __builtin_amdgcn_readfirstlane(tid >> 6), lane = tid & 63, wr = wid >> 2, wc = wid & 3, fr = lane & 15, fq = lane >> 4;
    const int K = g.K, nt = K / BK;
    unsigned voffA[2], voffB[2];
#pragma unroll
    for (int i = 0; i < 2; ++i) { int R, C; stage_rc(tid * 16 + i * 8192, R, C); const int Rb = Epi::PERM ? ((R & ~31) + perm32(R & 31)) : R;
        voffA[i] = (unsigned)(R * K + C) * 2u; voffB[i] = (unsigned)(Rb * K + C) * 2u; }
    const size_t kstep = (size_t)(BK * 2);
    const size_t hstep = (size_t)HALF * K * 2;
    const size_t tstep = 2 * hstep;
    const unsigned ldsw = (unsigned)wid * 1024u;
    const int aoff = lds_byte(wr * 64 + fr, fq * 8), boff = lds_byte(wc * 32 + fr, fq * 8);
#define PG8_SA(b, h) (((b) * 2 + (h)) * HTB)
#define PG8_SB(b, h) ((4 + (b) * 2 + (h)) * HTB)
#define PG8_STAGE(bufoff, gbase, voff) do { _Pragma("unroll") for (int _i = 0; _i < 2; ++_i) \
        __builtin_amdgcn_global_load_lds((const unsigned*)((const char*)(gbase) + (voff)[_i]), (PG8_LAS unsigned*)(lds + (bufoff) + ldsw + _i * 8192), 16, 0, 0); } while (0)
#define PG8_LDA(dst, b, h) do { _Pragma("unroll") for (int m = 0; m < 4; ++m) _Pragma("unroll") for (int k = 0; k < 2; ++k) dst[m][k] = *(const PG8_LAS bf16x8*)(lds + PG8_SA(b, h) + aoff + m * 2048 + k * 1024); } while (0)
#define PG8_LDB(dst, b, h) do { _Pragma("unroll") for (int n = 0; n < 2; ++n) _Pragma("unroll") for (int k = 0; k < 2; ++k) dst[n][k] = *(const PG8_LAS bf16x8*)(lds + PG8_SB(b, h) + boff + n * 2048 + k * 1024); } while (0)
#define PG8_MMA(ai, bj, At, Bt) do { __builtin_amdgcn_s_setprio(1); _Pragma("unroll") for (int m = 0; m < 4; ++m) _Pragma("unroll") for (int n = 0; n < 2; ++n) _Pragma("unroll") for (int k = 0; k < 2; ++k) \
        acc[ai][bj][m][n] = __builtin_amdgcn_mfma_f32_16x16x32_bf16(Bt[n][k], At[m][k], acc[ai][bj][m][n], 0, 0, 0); __builtin_amdgcn_s_setprio(0); } while (0)
#define PG8_WAIT_V(n) asm volatile("s_waitcnt vmcnt(" #n ")" ::: "memory")
#define PG8_WAIT_L(n) asm volatile("s_waitcnt lgkmcnt(" #n ")" ::: "memory")
#define PG8_BAR __builtin_amdgcn_s_barrier()
#define PG8_SCHED __builtin_amdgcn_sched_barrier(0)
    Unit cur, nxt; int ui = 0;
    if (!S.next(0, cur)) return;
    f32x4 acc[2][2][4][2];
#pragma unroll
    for (int a = 0; a < 2; ++a)
#pragma unroll
        for (int b = 0; b < 2; ++b)
#pragma unroll
            for (int m = 0; m < 4; ++m)
#pragma unroll
                for (int n = 0; n < 2; ++n) acc[a][b][m][n] = (f32x4){0.f, 0.f, 0.f, 0.f};
    bf16x8 At[4][2], B0[2][2], B1[2][2];
    const char* cA = (const char*)g.A + (size_t)cur.pm * tstep; const char* cB = (const char*)g.Bt + (size_t)cur.pn * tstep;
    S.a_ready(cur);
    if constexpr (SP2) {
        PG8_STAGE(PG8_SB(0, 0), cB, voffB); PG8_STAGE(PG8_SB(0, 1), cB + hstep, voffB); PG8_STAGE(PG8_SA(0, 0), cA, voffA); PG8_STAGE(PG8_SA(0, 1), cA + hstep, voffA);
        if (wr == 1) PG8_BAR;
        PG8_WAIT_V(2); PG8_BAR;
        PG8_STAGE(PG8_SB(1, 0), cB + kstep, voffB); PG8_STAGE(PG8_SA(1, 0), cA + kstep, voffA); PG8_STAGE(PG8_SB(1, 1), cB + hstep + kstep, voffB);
        PG8_WAIT_V(6); PG8_BAR;
    } else {
        PG8_STAGE(PG8_SB(0, 0), cB, voffB); PG8_STAGE(PG8_SA(0, 0), cA, voffA); PG8_STAGE(PG8_SB(0, 1), cB + hstep, voffB); PG8_STAGE(PG8_SA(0, 1), cA + hstep, voffA);
        if (wr == 1) PG8_BAR;
        PG8_WAIT_V(4); PG8_BAR;
        PG8_STAGE(PG8_SB(1, 0), cB + kstep, voffB); PG8_STAGE(PG8_SA(1, 0), cA + kstep, voffA); PG8_STAGE(PG8_SB(1, 1), cB + hstep + kstep, voffB);
        PG8_WAIT_V(6); PG8_BAR;
    }
    for (;;) {
        const bool has_next = S.next(ui + 1, nxt);
        const char* nA = has_next ? (const char*)g.A + (size_t)nxt.pm * tstep : cA; const char* nB = has_next ? (const char*)g.Bt + (size_t)nxt.pn * tstep : cB;
        for (int t = 0; t < nt; t += 2) {
            const bool last = (t == nt - 2);
            const char* a1 = cA + (size_t)(t + 1) * kstep;
            const char* a2 = last ? nA : cA + (size_t)(t + 2) * kstep; const char* b2 = last ? nB : cB + (size_t)(t + 2) * kstep;
            const char* a3 = a2 + kstep; const char* b3 = b2 + kstep;
            if (last && has_next) S.a_ready(nxt);
            if constexpr (SP2) {
            PG8_LDB(B0, 0, 0); PG8_LDB(B1, 0, 1); PG8_SCHED; PG8_LDA(At, 0, 0); PG8_STAGE(PG8_SA(1, 1), a1 + hstep, voffA);
            PG8_WAIT_V(8); PG8_WAIT_L(0); PG8_BAR; PG8_MMA(0, 0, At, B0); PG8_MMA(0, 1, At, B1); PG8_BAR; PG8_SCHED;
            PG8_LDA(At, 0, 1); PG8_STAGE(PG8_SB(0, 0), b2, voffB); PG8_STAGE(PG8_SB(0, 1), b2 + hstep, voffB); PG8_STAGE(PG8_SA(0, 0), a2, voffA);
            PG8_WAIT_V(8); PG8_WAIT_L(0); PG8_BAR; PG8_MMA(1, 0, At, B0); PG8_MMA(1, 1, At, B1); PG8_BAR; PG8_SCHED;
            PG8_LDB(B0, 1, 0); PG8_LDB(B1, 1, 1); PG8_SCHED; PG8_LDA(At, 1, 0); PG8_STAGE(PG8_SA(0, 1), a2 + hstep, voffA);
            PG8_WAIT_V(8); PG8_WAIT_L(0); PG8_BAR; PG8_MMA(0, 0, At, B0); PG8_MMA(0, 1, At, B1); PG8_BAR; PG8_SCHED;
            PG8_LDA(At, 1, 1); PG8_STAGE(PG8_SB(1, 0), b3, voffB); PG8_STAGE(PG8_SB(1, 1), b3 + hstep, voffB); PG8_STAGE(PG8_SA(1, 0), a3, voffA);
            PG8_WAIT_V(8); PG8_WAIT_L(0); PG8_BAR; PG8_MMA(1, 0, At, B0); PG8_MMA(1, 1, At, B1); PG8_BAR; PG8_SCHED;
            } else {
            PG8_LDB(B0, 0, 0); PG8_SCHED; PG8_LDA(At, 0, 0); PG8_STAGE(PG8_SA(1, 1), a1 + hstep, voffA);
            PG8_WAIT_L(8); PG8_BAR; PG8_WAIT_L(0); PG8_MMA(0, 0, At, B0); PG8_BAR; PG8_SCHED;
            PG8_LDB(B1, 0, 1); PG8_STAGE(PG8_SB(0, 0), b2, voffB);
            PG8_BAR; PG8_WAIT_L(0); PG8_MMA(0, 1, At, B1); PG8_BAR;
            PG8_LDA(At, 0, 1); PG8_STAGE(PG8_SA(0, 0), a2, voffA);
            PG8_BAR; PG8_WAIT_L(0); PG8_MMA(1, 0, At, B0); PG8_BAR; PG8_SCHED;
            PG8_STAGE(PG8_SB(0, 1), b2 + hstep, voffB);
            PG8_WAIT_V(6); PG8_BAR; PG8_MMA(1, 1, At, B1); PG8_BAR;
            PG8_LDB(B0, 1, 0); PG8_SCHED; PG8_LDA(At, 1, 0); PG8_STAGE(PG8_SA(0, 1), a2 + hstep, voffA);
            PG8_WAIT_L(8); PG8_BAR; PG8_WAIT_L(0); PG8_MMA(0, 0, At, B0); PG8_BAR; PG8_SCHED;
            PG8_LDB(B1, 1, 1); PG8_STAGE(PG8_SB(1, 0), b3, voffB);
            PG8_BAR; PG8_WAIT_L(0); PG8_MMA(0, 1, At, B1); PG8_BAR;
            PG8_LDA(At, 1, 1); PG8_STAGE(PG8_SA(1, 0), a3, voffA);
            PG8_BAR; PG8_WAIT_L(0); PG8_MMA(1, 0, At, B0); PG8_BAR; PG8_SCHED;
            PG8_STAGE(PG8_SB(1, 1), b3 + hstep, voffB);
            PG8_WAIT_V(6); PG8_BAR; PG8_MMA(1, 1, At, B1); PG8_BAR;
            }
        }
        if constexpr (ALIGN_EPI) { if (wr == 0) PG8_BAR; }
        if constexpr (!Epi::AFTER_DRAIN) { E(acc, cur, wr, wc, fr, fq); S.done(cur); }
        if (!has_next) break;
#pragma unroll
        for (int a = 0; a < 2; ++a)
#pragma unroll
            for (int b = 0; b < 2; ++b)
#pragma unroll
                for (int m = 0; m < 4; ++m)
#pragma unroll
                    for (int n = 0; n < 2; ++n) acc[a][b][m][n] = (f32x4){0.f, 0.f, 0.f, 0.f};
        cur = nxt; cA = nA; cB = nB; ++ui;
        if constexpr (ALIGN_EPI) { if (wr == 1) PG8_BAR; }
    }
    PG8_WAIT_V(0);
    if constexpr (!ALIGN_EPI) { if (wr == 0) PG8_BAR; }
    PG8_BAR;
    if constexpr (Epi::AFTER_DRAIN) { E.fused(acc, cur, wr, wc, fr, fq, lds, wid, lane); S.done(cur); }
#undef PG8_SA
#undef PG8_SB
#undef PG8_STAGE
#undef PG8_LDA
#undef PG8_LDB
#undef PG8_MMA
#undef PG8_WAIT_V
#undef PG8_WAIT_L
#undef PG8_BAR
#undef PG8_SCHED
}
}

#include <hip/hip_bf16.h>
#include <cmath>
namespace attn_body {
using bf16=__hip_bfloat16;
using bf16x8=__attribute__((ext_vector_type(8)))short;
using s16x4=__attribute__((ext_vector_type(4)))short;
using f32x16=__attribute__((ext_vector_type(16)))float;
using u32x4=__attribute__((ext_vector_type(4)))unsigned;
constexpr int SEQ=4096,D=64,DM=512;
constexpr int NW=8,QBLK=32,QB=QBLK*NW,KVBLK=64,NQB=SEQ/QB;
constexpr int ATTN_PITCH=DM, ATTN_UNIT_ROWS=QB;
__device__ __forceinline__ int crow(int r,int hi){return (r&3)+8*(r>>2)+4*hi;}
#define SBAR() __builtin_amdgcn_sched_barrier(0)
__device__ __forceinline__ void cmask(f32x16&p0,f32x16&p1,int jb,int qrel,int hi){
  const float NEG=-INFINITY; int kb=64*jb+4*hi;
  #pragma unroll
  for(int r=0;r<16;++r){int kv=kb+(r&3)+8*(r>>2); if(kv>qrel)p0[r]=NEG; if(kv+32>qrel)p1[r]=NEG;}
}

constexpr int NSLOT=3, SLOTB=8192;
constexpr int LDS_K=0, LDS_V=NSLOT*SLOTB, LDS_WS=2*NSLOT*SLOTB, LDS_OST=LDS_WS+NW*64*4, LDS_BYTES=LDS_OST+NW*4096;
constexpr float C2=0.125f*1.4426950408889634f;
__device__ __forceinline__ void glds16(const void*gsrc,unsigned lds_dst){unsigned keep;
  asm volatile("s_mov_b32 %0, m0\n\ts_mov_b32 m0, %2\n\ts_nop 0\n\tglobal_load_lds_dwordx4 %1, off\n\ts_mov_b32 m0, %0":"=&s"(keep):"v"(gsrc),"s"(lds_dst):"memory");}
__device__ __forceinline__ float max3f(float a,float b,float c){float r;asm("v_max3_f32 %0, %1, %2, %3":"=v"(r):"v"(a),"v"(b),"v"(c));return r;}
__device__ __forceinline__ float max2f(float a,float b){float r;asm("v_max_f32_e32 %0, %1, %2":"=v"(r):"v"(a),"v"(b));return r;}
__device__ __forceinline__ float fadd_s(float a,float b){float r;asm("v_add_f32_e32 %0, %1, %2":"=v"(r):"v"(a),"v"(b));return r;}
__device__ __forceinline__ float fsub_s(float a,float b){float r;asm("v_sub_f32_e32 %0, %1, %2":"=v"(r):"v"(a),"v"(b));return r;}
typedef float f32x2_t __attribute__((ext_vector_type(2))); typedef __bf16 bf16x2_t __attribute__((ext_vector_type(2)));
__device__ __forceinline__ unsigned cvtpk_s(float lo,float hi){f32x2_t v={lo,hi};bf16x2_t b=__builtin_convertvector(v,bf16x2_t);return __builtin_bit_cast(unsigned,b);}
#define WAIT_BAR(N) asm volatile("s_waitcnt vmcnt(" #N ") lgkmcnt(0)\n\ts_barrier":::"memory")

__device__ __forceinline__ void qkt(f32x16&p0,f32x16&p1,const char*Kslot,const bf16x8*qr,const f32x16&negm,int r32,int hi){
  const char*kb=Kslot+hi*1024+r32*16;
  #pragma unroll
  for(int d0=0;d0<4;++d0){
    const bf16x8 b0=*reinterpret_cast<const bf16x8*>(kb+d0*2048);
    const bf16x8 b1=*reinterpret_cast<const bf16x8*>(kb+d0*2048+512);
    if(d0==0){p0=__builtin_amdgcn_mfma_f32_32x32x16_bf16(b0,qr[0],negm,0,0,0);p1=__builtin_amdgcn_mfma_f32_32x32x16_bf16(b1,qr[0],negm,0,0,0);}
    else{p0=__builtin_amdgcn_mfma_f32_32x32x16_bf16(b0,qr[d0],p0,0,0,0);p1=__builtin_amdgcn_mfma_f32_32x32x16_bf16(b1,qr[d0],p1,0,0,0);}}
}
typedef __attribute__((address_space(3))) const char* lds_cptr;
typedef short v4i16_t __attribute__((ext_vector_type(4)));
__device__ __forceinline__ void kload8(bf16x8*kf,lds_cptr kp){
  kf[0]=*(const __attribute__((address_space(3))) bf16x8*)(kp);      kf[1]=*(const __attribute__((address_space(3))) bf16x8*)(kp+512);
  kf[2]=*(const __attribute__((address_space(3))) bf16x8*)(kp+2048); kf[3]=*(const __attribute__((address_space(3))) bf16x8*)(kp+2560);
  kf[4]=*(const __attribute__((address_space(3))) bf16x8*)(kp+4096); kf[5]=*(const __attribute__((address_space(3))) bf16x8*)(kp+4608);
  kf[6]=*(const __attribute__((address_space(3))) bf16x8*)(kp+6144); kf[7]=*(const __attribute__((address_space(3))) bf16x8*)(kp+6656);
}
__device__ __forceinline__ void kload2(bf16x8*kf,lds_cptr kp,int j){ kf[2*j]=*(const __attribute__((address_space(3))) bf16x8*)(kp+j*2048); kf[2*j+1]=*(const __attribute__((address_space(3))) bf16x8*)(kp+j*2048+512); }
__device__ __forceinline__ s16x4 vtr(lds_cptr p){ return __builtin_bit_cast(s16x4,__builtin_amdgcn_ds_read_tr16_b64_v4i16((__attribute__((address_space(3))) v4i16_t*)p)); }
__device__ __forceinline__ float rowmax(const f32x16&p0,const f32x16&p1){
  float a=max3f(p0[0],p0[1],p1[0]),b=max3f(p0[2],p0[3],p1[1]);a=max3f(a,p1[2],p1[3]);
  #pragma unroll
  for(int r=4;r<16;r+=4){a=max3f(a,p0[r],p0[r+1]);b=max3f(b,p0[r+2],p0[r+3]);a=max3f(a,p1[r],p1[r+1]);b=max3f(b,p1[r+2],p1[r+3]);}
  const float m=max2f(a,b);
  auto rr=__builtin_amdgcn_permlane32_swap(__float_as_uint(m),__float_as_uint(m),false,false);
  return max2f(__uint_as_float(rr[0]),__uint_as_float(rr[1]));
}
__device__ __forceinline__ void pv(f32x16*o,int vb,bf16x8 pa0,bf16x8 pa1,bf16x8 pa2,bf16x8 pa3){
  #pragma unroll
  for(int d0=0;d0<2;++d0){s16x4 lo[4],hi[4];
    #pragma unroll
    for(int ks=0;ks<4;++ks){
      asm volatile("ds_read_b64_tr_b16 %0,%1 offset:%c2":"=&v"(lo[ks]):"v"(vb),"i"(d0*4096+ks*1024):"memory");
      asm volatile("ds_read_b64_tr_b16 %0,%1 offset:%c2":"=&v"(hi[ks]):"v"(vb),"i"(d0*4096+ks*1024+512):"memory");}
    asm volatile("s_waitcnt lgkmcnt(0)":::"memory");SBAR();
    #define PK(k) (bf16x8){lo[k][0],lo[k][1],lo[k][2],lo[k][3],hi[k][0],hi[k][1],hi[k][2],hi[k][3]}
    o[d0]=__builtin_amdgcn_mfma_f32_32x32x16_bf16(pa0,PK(0),o[d0],0,0,0);
    o[d0]=__builtin_amdgcn_mfma_f32_32x32x16_bf16(pa1,PK(1),o[d0],0,0,0);
    o[d0]=__builtin_amdgcn_mfma_f32_32x32x16_bf16(pa2,PK(2),o[d0],0,0,0);
    o[d0]=__builtin_amdgcn_mfma_f32_32x32x16_bf16(pa3,PK(3),o[d0],0,0,0);
    #undef PK
  }
}

#ifndef ATTN_STORE16
#define ATTN_STORE16(p,v) (*(u32x4*)(p)=(v))
#endif
template<int THRL> __device__ __forceinline__ void attn_unit(int b,int cqk,int cvo,int qb,const bf16*Q,const bf16*__restrict__ K,const bf16*__restrict__ V,bf16*O,char*shm){
  const int tid=threadIdx.x,lane=tid&63,r32=lane&31,hi=lane>>5; const int wid=__builtin_amdgcn_readfirstlane(tid>>6);
  const long rowbase=(long)b*SEQ; const int q0=qb*QB;
  const bf16*Qw=Q+(rowbase+q0+wid*QBLK)*DM+cqk;
  const bf16*Kh=K+rowbase*DM+cqk,*Vh=V+rowbase*DM+cvo;
  const unsigned lds0=(unsigned)(uintptr_t)shm;
  float*wsf=(float*)(shm+LDS_WS)+wid*64;
  const bf16*ksrc=Kh+(long)lane*DM+wid*8;
  const bf16*vsrc=Vh+(long)(16*(wid&3)+(lane>>2))*DM+(wid>>2)*32+(lane&3)*8;
  const unsigned kdst=lds0+LDS_K+wid*1024, vdst=lds0+LDS_V+wid*1024;
  #define DMA_K(t,slot) glds16(ksrc+(long)(t)*KVBLK*DM,(unsigned)__builtin_amdgcn_readfirstlane(kdst+(slot)))
  #define DMA_V(t,slot) glds16(vsrc+(long)(t)*KVBLK*DM,(unsigned)__builtin_amdgcn_readfirstlane(vdst+(slot)))
  const int vb0=(int)(lds0+LDS_V)+((lane>>4)&1)*32+(lane&3)*8+(4*hi+((lane&15)>>2))*64;
  const char*Kbase=shm+LDS_K; bf16x8 kf[8];
  const lds_cptr shm3=(lds_cptr)shm; const lds_cptr kp0=shm3+LDS_K+hi*1024+r32*16; const lds_cptr vp0=shm3+LDS_V+((lane>>4)&1)*32+(lane&3)*8+(4*hi+((lane&15)>>2))*64;
  const int NT=SEQ/KVBLK;
  DMA_K(0,0);DMA_V(0,0);DMA_K(1,SLOTB);
  bf16x8 qr[4];
  #pragma unroll
  for(int d0=0;d0<4;++d0)qr[d0]=*reinterpret_cast<const bf16x8*>(&Qw[(long)r32*DM+d0*16+hi*8]);
  float mhat=0.f,l_reg=0.f;f32x16 o[2];o[0]=f32x16{};o[1]=f32x16{};f32x16 negm=f32x16{};asm volatile("":"+v"(negm));
  const int qrel=wid*QBLK+r32; (void)qrel;
  #define CMASK(P0,P1,t) do{}while(0)
  bool resc=false;
  #define START(P0,P1) do{ const float rm=rowmax(P0,P1); resc=false; \
    { const float dl=rm; mhat=fadd_s(mhat,dl); \
      _Pragma("unroll") for(int r=0;r<16;++r){P0[r]=fsub_s(P0[r],dl);P1[r]=fsub_s(P1[r],dl);} \
      _Pragma("unroll") for(int r=0;r<16;++r)negm[r]=-mhat; asm volatile("":"+v"(negm)); } \
    _Pragma("unroll") for(int r=0;r<16;++r)P0[r]=__builtin_amdgcn_exp2f(P0[r]); }while(0)
  #define RESC() do{ if(resc){ asm volatile("s_waitcnt lgkmcnt(0)":::"memory"); \
      _Pragma("unroll") for(int d_=0;d_<2;++d_) _Pragma("unroll") for(int r=0;r<16;++r)o[d_][r]*=wsf[crow(r,hi)]; } }while(0)
  f32x16 pA0,pA1,pB0,pB1;
  int sl_prev=0,sl_cur=0,sl_next=SLOTB;
  #define ROT() do{sl_prev=sl_cur;sl_cur=sl_next;sl_next=(sl_next==(NSLOT-1)*SLOTB)?0:sl_next+SLOTB;}while(0)
  DMA_K(2,2*SLOTB);
  WAIT_BAR(3);
  qkt(pA0,pA1,Kbase,qr,negm,r32,hi);asm volatile("s_nop 15\n\ts_nop 7":"+v"(pA0),"+v"(pA1));CMASK(pA0,pA1,0);
  START(pA0,pA1);
  _Pragma("unroll") for(int r=0;r<16;++r)pA1[r]=__builtin_amdgcn_exp2f(pA1[r]);
  WAIT_BAR(0);
  DMA_K(3,0);DMA_V(1,SLOTB);
  ROT();
  kload8(kf,kp0+sl_cur);
  WAIT_BAR(2);
  s16x4 vlo[8],vhi[8]; u32x4 pw0,pw1,pw2,pw3;
  #define PKW(P,B) cvtpk_s(P[B],P[B+1])
  #define PAF(k) __builtin_bit_cast(bf16x8,pw##k)
  #define VFR(i) (bf16x8){vlo[i][0],vlo[i][1],vlo[i][2],vlo[i][3],vhi[i][0],vhi[i][1],vhi[i][2],vhi[i][3]}
  #define PIN(x) asm volatile("":"+v"(x))
  #define MX3(a,b,c) __builtin_fmaxf(__builtin_fmaxf((a),(b)),(c))
  #define GAPA(MF,A0,A1,A2,A3,W0,W1,PW) do{ MF; sacc+=A0; sacc+=A1; sacc+=A2; sacc+=A3; PIN(sacc); W0; W1; PIN(PW); SBAR(); }while(0)
  #define EX(v) __builtin_amdgcn_exp2f(v)
  #define GAPB(MF,X,B) do{ MF; X[B]=EX(X[B]); X[B+1]=EX(X[B+1]); X[B+2]=EX(X[B+2]); X[B+3]=EX(X[B+3]); PIN(X); SBAR(); }while(0)
  #define VRD(i) do{ vlo[i]=vtr(vp_+(((i)>>2)*4096+((i)&3)*1024)); vhi[i]=vtr(vp_+(((i)>>2)*4096+((i)&3)*1024+512)); }while(0)
  #define KRD(G,j) do{ if(G){ kload2(kf,kp0+sl_next,j); SBAR(); } }while(0)
  #define STEP(C0,C1,P0,P1,t,GK,GV,GL) do{ SBAR(); \
    const lds_cptr vp_=vp0+sl_prev; \
    VRD(0); SBAR(); float sacc=(P0[0]+P0[1]); \
    GAPA(C0=__builtin_amdgcn_mfma_f32_32x32x16_bf16(kf[0],qr[0],negm,0,0,0), P0[2],P0[3],P0[4],P0[5],     pw0[0]=PKW(P0,0), pw0[1]=PKW(P0,2), pw0); \
    VRD(4); SBAR(); GAPA(C1=__builtin_amdgcn_mfma_f32_32x32x16_bf16(kf[1],qr[0],negm,0,0,0), P0[6],P0[7],P0[8],P0[9],     pw0[2]=PKW(P0,4), pw0[3]=PKW(P0,6), pw0); \
    VRD(1); SBAR(); GAPA(C0=__builtin_amdgcn_mfma_f32_32x32x16_bf16(kf[2],qr[1],C0,0,0,0),   P0[10],P0[11],P0[12],P0[13], pw1[0]=PKW(P0,8), pw1[1]=PKW(P0,10), pw1); \
    VRD(5); SBAR(); GAPA(C1=__builtin_amdgcn_mfma_f32_32x32x16_bf16(kf[3],qr[1],C1,0,0,0),   P0[14],P0[15],P1[0],P1[1],   pw1[2]=PKW(P0,12),pw1[3]=PKW(P0,14), pw1); \
    VRD(2); SBAR(); GAPA(C0=__builtin_amdgcn_mfma_f32_32x32x16_bf16(kf[4],qr[2],C0,0,0,0),   P1[2],P1[3],P1[4],P1[5],     pw2[0]=PKW(P1,0), pw2[1]=PKW(P1,2), pw2); \
    VRD(6); SBAR(); GAPA(C1=__builtin_amdgcn_mfma_f32_32x32x16_bf16(kf[5],qr[2],C1,0,0,0),   P1[6],P1[7],P1[8],P1[9],     pw2[2]=PKW(P1,4), pw2[3]=PKW(P1,6), pw2); \
    VRD(3); SBAR(); GAPA(C0=__builtin_amdgcn_mfma_f32_32x32x16_bf16(kf[6],qr[3],C0,0,0,0),   P1[10],P1[11],P1[12],P1[13], pw3[0]=PKW(P1,8), pw3[1]=PKW(P1,10), pw3); \
    VRD(7); SBAR(); GAPA(C1=__builtin_amdgcn_mfma_f32_32x32x16_bf16(kf[7],qr[3],C1,0,0,0),   P1[14],P1[15],0.f,0.f,       pw3[2]=PKW(P1,12),pw3[3]=PKW(P1,14), pw3); \
    l_reg+=sacc; \
    if(GK){DMA_K((t)+3,sl_cur);} if(GV){DMA_V((t)+1,sl_next);} \
    CMASK(C0,C1,t); \
    { float a=MX3(C0[0],C0[1],C1[0]),b=MX3(C0[2],C0[3],C1[1]); a=MX3(a,C1[2],C1[3]); \
      _Pragma("unroll") for(int r=4;r<16;r+=4){a=MX3(a,C0[r],C0[r+1]);b=MX3(b,C0[r+2],C0[r+3]);a=MX3(a,C1[r],C1[r+1]);b=MX3(b,C1[r+2],C1[r+3]);} \
      float rm=__builtin_fmaxf(a,b); { auto rr=__builtin_amdgcn_permlane32_swap(__float_as_uint(rm),__float_as_uint(rm),false,false); rm=__builtin_fmaxf(__uint_as_float(rr[0]),__uint_as_float(rr[1])); } \
      resc=false; \
      if(__builtin_expect(__any(rm>(float)THRL),0)){ const float dl=__builtin_fmaxf(rm,0.f); mhat+=dl; \
        _Pragma("unroll") for(int r=0;r<16;++r){C0[r]-=dl;C1[r]-=dl;} \
        _Pragma("unroll") for(int r=0;r<16;++r)negm[r]=-mhat; asm volatile("":"+v"(negm)); \
        const float f=__builtin_amdgcn_exp2f(-dl); l_reg*=f; if(hi==0)wsf[r32]=f; resc=true; } } \
    SBAR(); \
    GAPB(o[0]=__builtin_amdgcn_mfma_f32_32x32x16_bf16(PAF(0),VFR(0),o[0],0,0,0), C0,0); \
    GAPB(o[1]=__builtin_amdgcn_mfma_f32_32x32x16_bf16(PAF(0),VFR(4),o[1],0,0,0), C0,4); \
    KRD(GL,0); GAPB(o[0]=__builtin_amdgcn_mfma_f32_32x32x16_bf16(PAF(1),VFR(1),o[0],0,0,0), C0,8); \
    KRD(GL,1); GAPB(o[1]=__builtin_amdgcn_mfma_f32_32x32x16_bf16(PAF(1),VFR(5),o[1],0,0,0), C0,12); \
    KRD(GL,2); GAPB(o[0]=__builtin_amdgcn_mfma_f32_32x32x16_bf16(PAF(2),VFR(2),o[0],0,0,0), C1,0); \
    KRD(GL,3); GAPB(o[1]=__builtin_amdgcn_mfma_f32_32x32x16_bf16(PAF(2),VFR(6),o[1],0,0,0), C1,4); \
    GAPB(o[0]=__builtin_amdgcn_mfma_f32_32x32x16_bf16(PAF(3),VFR(3),o[0],0,0,0), C1,8); \
    GAPB(o[1]=__builtin_amdgcn_mfma_f32_32x32x16_bf16(PAF(3),VFR(7),o[1],0,0,0), C1,12); \
    }while(0)
  int t=1;
  #undef CMASK
  #define CMASK(P0,P1,t) do{}while(0)
  for(;t+5<NT;t+=2){
    STEP(pB0,pB1,pA0,pA1,t,true,true,true);     WAIT_BAR(2); RESC(); ROT();
    STEP(pA0,pA1,pB0,pB1,t+1,true,true,true);   WAIT_BAR(2); RESC(); ROT();
  }
  #undef CMASK
  #define CMASK(P0,P1,t) do{}while(0)
  #define ENDW(tt) do{ if((tt)+3<NT){WAIT_BAR(2);} else if((tt)+2<NT){WAIT_BAR(1);} else {WAIT_BAR(0);} }while(0)
  for(;t+1<NT;t+=2){
    STEP(pB0,pB1,pA0,pA1,t,(t+3<NT),(t+1<NT),(t+1<NT));       ENDW(t);   RESC(); ROT();
    STEP(pA0,pA1,pB0,pB1,t+1,(t+4<NT),(t+2<NT),(t+2<NT));     ENDW(t+1); RESC(); ROT();
  }
  STEP(pB0,pB1,pA0,pA1,NT-1,false,false,false); RESC();
  { float sacc=pB0[0]+pB0[1]; _Pragma("unroll") for(int r=2;r<16;++r)sacc+=pB0[r]; _Pragma("unroll") for(int r=0;r<16;++r)sacc+=pB1[r]; l_reg+=sacc;
    pw0=(u32x4){PKW(pB0,0),PKW(pB0,2),PKW(pB0,4),PKW(pB0,6)};pw1=(u32x4){PKW(pB0,8),PKW(pB0,10),PKW(pB0,12),PKW(pB0,14)};pw2=(u32x4){PKW(pB1,0),PKW(pB1,2),PKW(pB1,4),PKW(pB1,6)};pw3=(u32x4){PKW(pB1,8),PKW(pB1,10),PKW(pB1,12),PKW(pB1,14)};
    SBAR(); pv(o,vb0+sl_cur,PAF(0),PAF(1),PAF(2),PAF(3)); }
  #undef PKW
  #undef PAF
  #undef VFR
  #undef PIN
  #undef MX3
  #undef GAPA
  #undef GAPB
  #undef EX
  #undef VRD
  #undef KRD
  #undef STEP
  #undef ENDW
  {auto rr=__builtin_amdgcn_permlane32_swap(__float_as_uint(l_reg),__float_as_uint(l_reg),false,false);l_reg=__uint_as_float(rr[0])+__uint_as_float(rr[1]);}
  if(hi==0)wsf[32+r32]=l_reg;asm volatile("s_waitcnt lgkmcnt(0)":::"memory");
  float rli[16];
  #pragma unroll
  for(int r=0;r<16;++r)rli[r]=__builtin_amdgcn_rcpf(wsf[32+crow(r,hi)]);
  bf16*Ow=O+(rowbase+q0+wid*QBLK)*DM+cvo;
  { bf16*stg=(bf16*)(shm+LDS_OST)+wid*2048;
    #pragma unroll
    for(int r=0;r<16;++r){const int orow=crow(r,hi);
      #pragma unroll
      for(int d0=0;d0<2;++d0)stg[orow*64+d0*32+r32]=__float2bfloat16(o[d0][r]*rli[r]);}
    asm volatile("s_waitcnt lgkmcnt(0)":::"memory");
    #pragma unroll
    for(int i=0;i<4;++i){const int row=i*8+(lane>>3),ch=lane&7; const u32x4 v=*(const u32x4*)(stg+row*64+ch*8); ATTN_STORE16(Ow+(long)row*DM+ch*8,v);} }
  asm volatile("s_waitcnt lgkmcnt(0)\n\ts_barrier":::"memory");
  #undef DMA_K
  #undef DMA_V
  #undef CMASK
  #undef START
  #undef RESC
  #undef ROT
}
constexpr int ATTN_LDS_BYTES=LDS_BYTES;
#undef SBAR
#undef WAIT_BAR
}

namespace dil {
constexpr int D = 128;
constexpr float THR = 8.f;
constexpr bool WSKIP = true;
constexpr float SCALE = 0.08838834764831845f;
constexpr int NW = 8, QBLK = 32, KVBLK = 64, QB = NW * QBLK;
constexpr int SHM_V = KVBLK * D * 2, SHM_K = KVBLK * D * 2;
constexpr int LDS_BYTES = 2 * SHM_V + 2 * SHM_K + NW * 64 * 4;
using bf16 = __hip_bfloat16;
typedef short bf16x8 __attribute__((ext_vector_type(8)));
typedef short s16x4 __attribute__((ext_vector_type(4)));
typedef float f32x16 __attribute__((ext_vector_type(16)));
typedef float f32x4 __attribute__((ext_vector_type(4)));
typedef unsigned u32x4 __attribute__((ext_vector_type(4)));
template <class A, class Bt> struct same_t { static constexpr bool v = false; };
template <class A> struct same_t<A, A> { static constexpr bool v = true; };

#define KSWZ(row, colB) ((row) * 256 + ((colB) ^ (((row) & 7) << 4)))
#define SBAR() __builtin_amdgcn_sched_barrier(0)
__device__ __forceinline__ int v_st(int k, int c) { const int kk = (k & ~0xC) | ((k & 4) << 1) | ((k & 8) >> 1); return ((kk >> 3) * 4 + (c >> 5)) * 512 + ((kk & 7) * 32 + (c & 31)) * 2; }
__device__ __forceinline__ int v_rd_base(int lane) { return ((lane & 3) << 3) | (((lane >> 2) & 3) << 6) | (((lane >> 4) & 1) << 5) | (((lane >> 5) & 1) << 8); }
constexpr int v_rd_off(int d0, int ks, int half) { return d0 * 512 + ks * 4096 + half * 2048; }
__device__ __forceinline__ int crow(int r, int hi) { return (r & 3) + 8 * (r >> 2) + 4 * hi; }
__device__ __forceinline__ unsigned cvtpk(float lo, float hi) {
    unsigned r; asm volatile("v_cvt_pk_bf16_f32 %0, %1, %2" : "=v"(r) : "v"(lo), "v"(hi)); return r;
}
__device__ __forceinline__ bf16x8 pack8(f32x4 a, f32x4 b) {
    u32x4 w = {cvtpk(a[0], a[1]), cvtpk(a[2], a[3]), cvtpk(b[0], b[1]), cvtpk(b[2], b[3])};
    return *reinterpret_cast<bf16x8*>(&w);
}
template <class T> __device__ __forceinline__ bf16x8 load8(const T* p) {
    if constexpr (same_t<T, float>::v) { return pack8(*(const f32x4*)p, *(const f32x4*)(p + 4)); }
    else { return *reinterpret_cast<const bf16x8*>(p); }
}
__device__ __forceinline__ void mask_tile(f32x16& p0, f32x16& p1, int dq, unsigned W) {
    const float NEG = -__builtin_inff();
#pragma unroll
    for (int r = 0; r < 16; ++r) {
        const int c = (r & 3) + 8 * (r >> 2);
        if ((unsigned)(dq - c) >= W) p0[r] = NEG;
        if ((unsigned)(dq - c - 32) >= W) p1[r] = NEG;
    }
}
__device__ __forceinline__ void partialSM(f32x16& p0, f32x16& p1, float& m_reg, float& mn, float& alpha) {
    float pmax = p0[0]; for (int r = 1; r < 16; ++r) pmax = fmaxf(pmax, p0[r]); for (int r = 0; r < 16; ++r) pmax = fmaxf(pmax, p1[r]);
    { auto rr = __builtin_amdgcn_permlane32_swap(__float_as_uint(pmax), __float_as_uint(pmax), false, false);
      pmax = fmaxf(__uint_as_float(rr[0]), __uint_as_float(rr[1])); }
    constexpr float C2 = 1.4426950408889634f * SCALE;
    if (__builtin_expect(__all((pmax - m_reg) * SCALE <= THR), 1)) { mn = m_reg; alpha = 1.f; }
    else { mn = fmaxf(m_reg, pmax); alpha = __builtin_amdgcn_exp2f((m_reg - mn) * C2); m_reg = mn; }
    const float mnL = -mn * C2;
    for (int r = 0; r < 16; ++r) p0[r] = fmaf(p0[r], C2, mnL); for (int r = 0; r < 16; ++r) p1[r] = fmaf(p1[r], C2, mnL);
    for (int r = 0; r < 16; ++r) p0[r] = __builtin_amdgcn_exp2f(p0[r]);
}
__device__ __forceinline__ void finishSM(f32x16& p0, f32x16& p1, float alpha, float& l_reg, bf16x8& pa0, bf16x8& pa1, bf16x8& pa2, bf16x8& pa3) {
    for (int r = 0; r < 16; ++r) p1[r] = __builtin_amdgcn_exp2f(p1[r]);
    float ps = 0; for (int r = 0; r < 16; ++r) ps += p0[r]; for (int r = 0; r < 16; ++r) ps += p1[r];
    { auto rr = __builtin_amdgcn_permlane32_swap(__float_as_uint(ps), __float_as_uint(ps), false, false);
      ps = __uint_as_float(rr[0]) + __uint_as_float(rr[1]); }
    l_reg = l_reg * alpha + ps;
#define PK4(P, B_, OUT) do { unsigned a0 = cvtpk(P[B_+0], P[B_+1]), a1 = cvtpk(P[B_+2], P[B_+3]);                          \
        unsigned b0 = cvtpk(P[B_+4], P[B_+5]), b1 = cvtpk(P[B_+6], P[B_+7]);                                             \
        auto r0 = __builtin_amdgcn_permlane32_swap(a0, b0, false, false); auto r1 = __builtin_amdgcn_permlane32_swap(a1, b1, false, false); \
        u32x4 w = {r0[0], r1[0], r0[1], r1[1]}; OUT = *reinterpret_cast<bf16x8*>(&w); } while (0)
    PK4(p0, 0, pa0); PK4(p0, 8, pa1); PK4(p1, 0, pa2); PK4(p1, 8, pa3);
#undef PK4
}
template <int KB, bool SK>
__device__ __forceinline__ void qkt(f32x16& p0, f32x16& p1, const char* K_lds, int r32, int hi, const bf16x8* qr, bool act) {
    if (SK && !act) { const float NEG = -__builtin_inff();
#pragma unroll
        for (int r = 0; r < 16; ++r) { p0[r] = NEG; p1[r] = NEG; } return; }
    p0 = f32x16{}; p1 = f32x16{};
    const char* kb[4];
#pragma unroll
    for (int dd = 0; dd < 4; ++dd) kb[dd] = K_lds + KB * SHM_K + KSWZ(r32, (dd * 16 + hi * 8) * 2);
#pragma unroll
    for (int d0 = 0; d0 < 8; ++d0) { const char* a = kb[d0 & 3] + (d0 >> 2) * 128;
        bf16x8 b0 = *reinterpret_cast<const bf16x8*>(a);
        bf16x8 b1 = *reinterpret_cast<const bf16x8*>(a + 32 * 256);
        p0 = __builtin_amdgcn_mfma_f32_32x32x16_bf16(b0, qr[d0], p0, 0, 0, 0);
        p1 = __builtin_amdgcn_mfma_f32_32x32x16_bf16(b1, qr[d0], p1, 0, 0, 0); }
}
template <int VB, bool SK>
__device__ __forceinline__ void pv_tile(f32x16* o, int vb0, bf16x8 pa0, bf16x8 pa1, bf16x8 pa2, bf16x8 pa3, bool act) {
    if (SK && !act) return;
#define TRRD(dst, off) asm volatile("ds_read_b64_tr_b16 %0, %1 offset:%2" : "=&v"(dst) : "v"(vb0), "i"(off) : "memory")
#define PV_D0(d0) do { s16x4 l0, l1, l2, l3, h0, h1, h2, h3; constexpr int b_ = VB * SHM_V + v_rd_off(d0, 0, 0);     \
        TRRD(l0, b_); TRRD(h0, b_ + 2048); TRRD(l1, b_ + 4096); TRRD(h1, b_ + 6144); TRRD(l2, b_ + 8192); TRRD(h2, b_ + 10240); TRRD(l3, b_ + 12288); TRRD(h3, b_ + 14336); \
        asm volatile("s_waitcnt lgkmcnt(0)" ::: "memory"); SBAR();                 \
        o[d0] = __builtin_amdgcn_mfma_f32_32x32x16_bf16(pa0, (bf16x8){l0[0], l0[1], l0[2], l0[3], h0[0], h0[1], h0[2], h0[3]}, o[d0], 0, 0, 0);   \
        o[d0] = __builtin_amdgcn_mfma_f32_32x32x16_bf16(pa1, (bf16x8){l1[0], l1[1], l1[2], l1[3], h1[0], h1[1], h1[2], h1[3]}, o[d0], 0, 0, 0);   \
        o[d0] = __builtin_amdgcn_mfma_f32_32x32x16_bf16(pa2, (bf16x8){l2[0], l2[1], l2[2], l2[3], h2[0], h2[1], h2[2], h2[3]}, o[d0], 0, 0, 0);   \
        o[d0] = __builtin_amdgcn_mfma_f32_32x32x16_bf16(pa3, (bf16x8){l3[0], l3[1], l3[2], l3[3], h3[0], h3[1], h3[2], h3[3]}, o[d0], 0, 0, 0); } while (0)
    PV_D0(0); PV_D0(1); PV_D0(2); PV_D0(3);
#undef PV_D0
#undef TRRD
}

template <class TIn, class TOut> struct BlockRef { const TIn* Q; const TIn* K; const TIn* V; TOut* O; float* LSE; int P0; int rs; int lrs; int skv; };
template <class TIn> struct Seam {
    bf16x8 qr[8];
    bf16x8 st_v0, st_v1, st_k0, st_k1; f32x4 sf0, sf1, sf2, sf3;
    f32x4 tq[16];
};
__device__ __forceinline__ int swa_jlo(int P0, int W) { const int lowk = P0 - 64; (void)W; return lowk > 0 ? lowk / KVBLK : 0; }
#define ROW(p, k0, rr) ((p) + (size_t)((k0) + (rr)) * RS_ + sc)
#define VMW() asm volatile("s_waitcnt vmcnt(0)" ::: "memory")
#define VMWN(n) asm volatile("s_waitcnt vmcnt(%0)" :: "i"(n) : "memory")
#define SLOAD_H(Kp, Vp, k0) do { S.st_v0 = load8<TIn>(ROW(Vp, k0, sr)); S.st_v1 = load8<TIn>(ROW(Vp, k0, 32 + sr));              \
                         S.st_k0 = load8<TIn>(ROW(Kp, k0, sr)); S.st_k1 = load8<TIn>(ROW(Kp, k0, 32 + sr)); } while (0)
#define SWRITE_HK(bf) do { *(bf16x8*)(K_lds + (bf) * SHM_K + kws) = S.st_k0; *(bf16x8*)(K_lds + (bf) * SHM_K + kws + 32 * 256) = S.st_k1; } while (0)
#define SWRITE_HV(bf) do { *(bf16x8*)(V_lds + (bf) * SHM_V + vst0) = S.st_v0; *(bf16x8*)(V_lds + (bf) * SHM_V + vst1) = S.st_v1; } while (0)
#define SWRITE_H(bf) do { SWRITE_HV(bf); SWRITE_HK(bf); } while (0)
#define SLOAD_F(p, k0) do { S.sf0 = *(const f32x4*)ROW(p, k0, sr); S.sf1 = *(const f32x4*)(ROW(p, k0, sr) + 4);                \
                            S.sf2 = *(const f32x4*)ROW(p, k0, 32 + sr); S.sf3 = *(const f32x4*)(ROW(p, k0, 32 + sr) + 4); } while (0)
#define SWRITE_KF(bf) do { *(bf16x8*)(K_lds + (bf) * SHM_K + kws) = pack8(S.sf0, S.sf1); *(bf16x8*)(K_lds + (bf) * SHM_K + kws + 32 * 256) = pack8(S.sf2, S.sf3); } while (0)
#define SWRITE_VF(bf) do { *(bf16x8*)(V_lds + (bf) * SHM_V + vst0) = pack8(S.sf0, S.sf1); *(bf16x8*)(V_lds + (bf) * SHM_V + vst1) = pack8(S.sf2, S.sf3); } while (0)
template <class TIn, class TOut>
__device__ __forceinline__ void causal_swa_prime(const BlockRef<TIn, TOut>& cur, int W, char* lds, Seam<TIn>& S) {
    constexpr bool F32 = same_t<TIn, float>::v;
    const int tid = threadIdx.x, wid = __builtin_amdgcn_readfirstlane(tid >> 6), lane = tid & 63, r32 = lane & 31, hi = lane >> 5;
    const int sr = tid >> 4, sc = (tid & 15) * 8, kws = KSWZ(sr, sc * 2); char* K_lds = lds + 2 * SHM_V;
    const int kb0 = swa_jlo(cur.P0, W) * KVBLK; const size_t RS_ = (size_t)cur.rs;
    for (int d0 = 0; d0 < 8; ++d0) S.qr[d0] = load8<TIn>(cur.Q + (size_t)(wid * QBLK + r32) * RS_ + d0 * 16 + hi * 8);
    if constexpr (F32) { SLOAD_F((const float*)cur.K, kb0); VMW(); SWRITE_KF(0); SBAR(); SLOAD_F((const float*)cur.V, kb0); }
    else { SLOAD_H(cur.K, cur.V, kb0); VMW(); SWRITE_HK(0); }
    __syncthreads();
}
template <class TIn, class TOut>
__device__ __forceinline__ void causal_swa_block(const BlockRef<TIn, TOut>& cur, const BlockRef<TIn, TOut>& nxt, int W, char* lds, Seam<TIn>& S) {
    constexpr bool F32 = same_t<TIn, float>::v;
    const int tid = threadIdx.x, wid = __builtin_amdgcn_readfirstlane(tid >> 6), lane = tid & 63, r32 = lane & 31, hi = lane >> 5;
    const int j_lo = swa_jlo(cur.P0, W);
    int j_hi = (cur.P0 + QB - 1 + 64) / KVBLK + 1; if (j_hi > cur.skv / KVBLK) j_hi = cur.skv / KVBLK;
    const int NT = j_hi - j_lo;
    const int kbn = swa_jlo(nxt.P0, W) * KVBLK;
    const int qlo = cur.P0 + wid * QBLK, qm = qlo + r32 - 4 * hi;
    char* V_lds = lds; char* K_lds = lds + 2 * SHM_V;
    float* ws = (float*)(lds + 2 * SHM_V + 2 * SHM_K) + wid * 64; float* li_l = ws, * al_l = ws + 32;
    float m_reg = -1e30f, l_reg = 0; f32x16 o[4] = {};
    const int sr = tid >> 4, sc = (tid & 15) * 8, vst0 = v_st(sr, sc), vst1 = v_st(32 + sr, sc), kws = KSWZ(sr, sc * 2);
    const int vb0 = (int)(uintptr_t)V_lds + v_rd_base(lane);
    const TIn* Kh = cur.K; const TIn* Vh = cur.V; size_t RS_ = (size_t)cur.rs;
#define RESC(a) do { if (__any((a) < 1.f)) { if (hi == 0) al_l[r32] = (a); asm volatile("s_waitcnt lgkmcnt(0)" ::: "memory");              \
                     for (int d_ = 0; d_ < 4; ++d_) for (int r = 0; r < 16; ++r) o[d_][r] *= al_l[crow(r, hi)]; } } while (0)
#define KBASE(t) ((j_lo + (t)) * KVBLK)
#define ACT(t) (KBASE(t) <= qlo + QBLK - 1 + 64 && KBASE(t) + KVBLK - 1 >= qlo - 64)
#define MASKT(P0_, P1_, t) do { const int kb_ = KBASE(t); if (!SK || ACT(t)) mask_tile(P0_, P1_, qm - kb_ + 64, 129u); } while (0)
    constexpr int NQL = F32 ? 16 : 8;
    constexpr bool SK = WSKIP && !F32;
#define SEAM_K0() do { VMWN(NQL); if constexpr (F32) { SWRITE_KF(0); SBAR(); SLOAD_F((const float*)nxt.V, kbn); } else { SWRITE_HK(0); } SBAR(); } while (0)
    f32x16 pA0, pA1, pB0, pB1; float mnA, mnB, alA, alB; bf16x8 pa0, pa1, pa2, pa3;
    if constexpr (F32) { VMW(); SWRITE_VF(0); SBAR(); } else { SWRITE_HV(0); SBAR(); }
    if (NT > 1) { if constexpr (F32) SLOAD_F((const float*)Kh, KBASE(1)); else SLOAD_H(Kh, Vh, KBASE(1)); }
    SBAR(); qkt<0, SK>(pA0, pA1, K_lds, r32, hi, S.qr, ACT(0));
    if constexpr (F32) { if (NT > 1) { VMW(); SWRITE_KF(1); SBAR(); SLOAD_F((const float*)Vh, KBASE(1)); } }
    MASKT(pA0, pA1, 0); partialSM(pA0, pA1, m_reg, mnA, alA);
    if (NT > 1) { VMW(); if constexpr (F32) { SWRITE_VF(1); SBAR(); if (NT > 2) SLOAD_F((const float*)Kh, KBASE(2)); } else SWRITE_H(1); }
    __syncthreads();
#define HALF_STEP(PX0, PX1, mnX, alX, PY0, PY1, alY, t, KB, VB, SB) do {                                                      \
        SBAR(); qkt<KB, SK>(PX0, PX1, K_lds, r32, hi, S.qr, ACT(t));                                             \
        finishSM(PY0, PY1, alY, l_reg, pa0, pa1, pa2, pa3); SBAR();                                                           \
        if ((t) + 1 < NT) { if constexpr (F32) { VMW(); SWRITE_KF(SB); SBAR(); SLOAD_F((const float*)Vh, KBASE((t) + 1)); }  \
                            else { SLOAD_H(Kh, Vh, KBASE((t) + 1)); } SBAR(); }                                               \
        pv_tile<VB, SK>(o, vb0, pa0, pa1, pa2, pa3, ACT((t) - 1)); MASKT(PX0, PX1, (t)); partialSM(PX0, PX1, m_reg, mnX, alX);                                        \
        __syncthreads();                                                                                                      \
        if ((t) + 1 < NT) { VMW(); if constexpr (F32) { SWRITE_VF(SB); SBAR(); if ((t) + 2 < NT) SLOAD_F((const float*)Kh, KBASE((t) + 2)); } \
                            else { SWRITE_H(SB); } }                                                                          \
        RESC(alX); __syncthreads(); } while (0)
    for (int t = 1; t + 1 < NT; t += 2) {
        HALF_STEP(pB0, pB1, mnB, alB, pA0, pA1, alA, t, 1, 0, 0);
        HALF_STEP(pA0, pA1, mnA, alA, pB0, pB1, alB, t + 1, 0, 1, 1);
    }
    const bool even = (NT & 1) == 0;
    if (even) { SBAR(); qkt<1, SK>(pB0, pB1, K_lds, r32, hi, S.qr, ACT(NT - 1)); SBAR(); }
#define QROW(e) (nxt.Q + (size_t)(wid * QBLK + r32) * (size_t)nxt.rs + ((e) >> 1) * 16 + hi * 8 + ((e) & 1) * 4)
    RS_ = (size_t)nxt.rs;
    if constexpr (F32) { SLOAD_F((const float*)nxt.K, kbn); SBAR();
#pragma unroll
        for (int e = 0; e < 8; ++e) S.tq[e] = *(const f32x4*)QROW(e); }
    else { SLOAD_H(nxt.K, nxt.V, kbn); SBAR();
#pragma unroll
        for (int d0 = 0; d0 < 8; ++d0) S.qr[d0] = load8<TIn>(nxt.Q + (size_t)(wid * QBLK + r32) * (size_t)nxt.rs + d0 * 16 + hi * 8); }
    SBAR();
    finishSM(pA0, pA1, alA, l_reg, pa0, pa1, pa2, pa3); SBAR();
    if constexpr (F32) {
#pragma unroll
        for (int e = 8; e < 16; ++e) S.tq[e] = *(const f32x4*)QROW(e); SBAR(); }
#undef QROW
    pv_tile<0, SK>(o, vb0, pa0, pa1, pa2, pa3, ACT(even ? NT - 2 : NT - 1));
    if (even) { MASKT(pB0, pB1, NT - 1); partialSM(pB0, pB1, m_reg, mnB, alB); __syncthreads(); RESC(alB);
        finishSM(pB0, pB1, alB, l_reg, pa0, pa1, pa2, pa3); SBAR(); pv_tile<1, SK>(o, vb0, pa0, pa1, pa2, pa3, ACT(NT - 1)); }
    SBAR(); SEAM_K0();
    if (hi == 0) { li_l[r32] = l_reg; cur.LSE[(size_t)(wid * QBLK + r32) * (size_t)cur.lrs] = m_reg * SCALE + __builtin_amdgcn_logf(l_reg) * 0.6931471805599453f; }
    asm volatile("s_waitcnt lgkmcnt(0)" ::: "memory");
    float rli[16];
#pragma unroll
    for (int r = 0; r < 16; ++r) rli[r] = __builtin_amdgcn_rcpf(li_l[crow(r, hi)]);
    const size_t ORS = (size_t)cur.rs; TOut* Ow = cur.O + (size_t)(wid * QBLK) * ORS;
#pragma unroll
    for (int r = 0; r < 16; ++r) { const int orow = crow(r, hi);
#pragma unroll
        for (int d0 = 0; d0 < 4; ++d0) { const float v = o[d0][r] * rli[r];
            if constexpr (same_t<TOut, float>::v) { Ow[(size_t)orow * ORS + d0 * 32 + r32] = v; }
            else { const float vn = __shfl_xor(v, 1);
                   if ((r32 & 1) == 0) *(unsigned*)(Ow + (size_t)orow * ORS + d0 * 32 + r32) = cvtpk(v, vn); } } }
    if constexpr (F32) {
#pragma unroll
        for (int d0 = 0; d0 < 8; ++d0) S.qr[d0] = pack8(S.tq[2 * d0], S.tq[2 * d0 + 1]); }
    __syncthreads();
#undef RESC
#undef KBASE
#undef ACT
#undef MASKT
#undef SEAM_K0
#undef HALF_STEP
}
#undef ROW
#undef VMW
#undef VMWN
#undef SLOAD_H
#undef SWRITE_HK
#undef SWRITE_HV
#undef SWRITE_H
#undef SLOAD_F
#undef SWRITE_KF
#undef SWRITE_VF
}

constexpr int NWAVES = 8;
constexpr int M = 16384, SEQ = 4096, DMODEL = 2048, INW = 6144;
constexpr int NEXP = 16384;
constexpr float LN_EPS = 1e-5f;
constexpr float ALPHA = 1.189207115002721f;
constexpr float LAM_INIT = 0.2f;
constexpr int N_LAUNCHES = MK_N_LAUNCHES, PER_PHASE = 9;

constexpr size_t MiB = 1u << 20;
constexpr size_t WS_CTL = 0, CTL_ZERO_BYTES = 1 * MiB;
constexpr size_t WS_KEYS = 1 * MiB;
constexpr size_t WS_ROPEA = 1 * MiB + 512 * 1024;
constexpr size_t WS_ROPED = 2 * MiB;
constexpr size_t WS_LSE = 2 * MiB + 256 * 1024;
constexpr size_t WS_WOUT = 5 * MiB, WS_WQ = 13 * MiB, WS_WIN = 21 * MiB;
constexpr size_t WS_XN = 46 * MiB;
constexpr size_t WS_QA = 110 * MiB, WS_KA = 158 * MiB, WS_VA = 206 * MiB;
constexpr size_t WS_QD = 254 * MiB, WS_KD = 270 * MiB, WS_VD = 286 * MiB;
constexpr size_t WS_OC = 302 * MiB;
constexpr size_t WS_OD = 446 * MiB;
constexpr size_t WS_MIXED = 110 * MiB;
constexpr size_t WS_PRE = 302 * MiB;
constexpr size_t WS_H1 = 174 * MiB;
constexpr size_t WS_QP = 238 * MiB;
constexpr size_t WS_U16 = 46 * MiB, WS_V16 = 110 * MiB;
constexpr size_t WS_IDX = 430 * MiB, WS_G = 438 * MiB;
constexpr size_t WS_END = 480 * MiB;
constexpr int CW_BAR = 4096;

constexpr int RING_OFF = 0, RING_BYTES = 131072;
constexpr int LDSCTL_OFF = RING_BYTES, MISC_OFF = LDSCTL_OFF + 320;
constexpr int LDS_BYTES = 147456;
static_assert(MISC_OFF + 128 <= LDS_BYTES && attn_body::ATTN_LDS_BYTES <= RING_BYTES && dil::LDS_BYTES <= RING_BYTES, "LDS map");

#define GAS __attribute__((address_space(1)))
#define LAS __attribute__((address_space(3)))
typedef unsigned short bf16;
typedef unsigned v4u __attribute__((ext_vector_type(4)));
typedef float f32x4 __attribute__((ext_vector_type(4)));
typedef short bf16x8 __attribute__((ext_vector_type(8)));
typedef GAS unsigned gu32;
typedef GAS unsigned long long gu64;
#define RLX_AGENT __ATOMIC_RELAXED, __HIP_MEMORY_SCOPE_AGENT
#define LDS_WAIT() asm volatile("s_waitcnt lgkmcnt(0)" ::: "memory")
#define VM_WAIT() asm volatile("s_waitcnt vmcnt(0)" ::: "memory")
__device__ __forceinline__ unsigned long long rt() { return __builtin_amdgcn_s_memrealtime(); }
__device__ __forceinline__ unsigned f2bf(float f) { unsigned u = __builtin_bit_cast(unsigned, f); return (u + 0x7fffu + ((u >> 16) & 1u)) >> 16; }
__device__ __forceinline__ unsigned pk2(float lo, float hi) { return f2bf(lo) | (f2bf(hi) << 16); }

#define XB_TMO      128
#define XB_XCNT(j)  (256  + 64 * (j))
#define XB_XSUB(j)  (1280 + 64 * (j))
#define XB_XGEN(j)  (2304 + 64 * (j))
#define XB_TOP      3328
#define XB_TOPGEN   3392
#define XCD_BAR_WORDS 3456
#define XB_SPIN_CAP (1u << 18)

__device__ __forceinline__ unsigned xb_ld(unsigned* p)              { return __hip_atomic_load(p, __ATOMIC_RELAXED, __HIP_MEMORY_SCOPE_AGENT); }
__device__ __forceinline__ unsigned xb_add(unsigned* p, unsigned v) { return __hip_atomic_fetch_add(p, v, __ATOMIC_RELAXED, __HIP_MEMORY_SCOPE_AGENT); }
__device__ __forceinline__ unsigned xb_xcc_id() { return (unsigned)__builtin_amdgcn_s_getreg((3 << 11) | 20) & 0xFu; }
#define XB_SPIN(cond, bar) do { unsigned _sp = 0; while (cond) { __builtin_amdgcn_s_sleep(1); \
    if ((++_sp & 255u) == 0u) { if (xb_ld(&(bar)[XB_TMO])) break; if (_sp > XB_SPIN_CAP) { atomicAdd(&(bar)[XB_TMO], 1u); break; } } } } while (0)

struct XcdBarrier {
    unsigned* bar; unsigned x;
    volatile LAS unsigned* st;
};

__device__ __forceinline__ XcdBarrier xcd_barrier_post(unsigned* bar, volatile LAS unsigned* st) {
    XcdBarrier b; b.bar = bar; b.x = xb_xcc_id(); b.st = st;
    if (threadIdx.x == 0) (void)xb_add(&bar[XB_XCNT(b.x)], 1u);
    return b;
}
__device__ __forceinline__ void xcd_barrier_complete(unsigned* bar, unsigned x, unsigned& nloc, unsigned& nx) {
    const unsigned G = gridDim.x * gridDim.y * gridDim.z;
    unsigned sum, cnt, mine, sp = 0u;
    for (;;) {
        sum = 0u; cnt = 0u; mine = 0u;
#pragma unroll
        for (unsigned j = 0; j < 16; ++j) { const unsigned c = xb_ld(&bar[XB_XCNT(j)]); sum += c; cnt += (c > 0u) ? 1u : 0u; mine = (j == x) ? c : mine; }
        if (sum == G) break;
        __builtin_amdgcn_s_sleep(1);
        if ((++sp & 255u) == 0u) { if (xb_ld(&bar[XB_TMO])) break; if (sp > XB_SPIN_CAP) { atomicAdd(&bar[XB_TMO], 1u); break; } }
    }
    nloc = mine > 0u ? mine : 1u; nx = cnt > 0u ? cnt : 1u;
}

__device__ __forceinline__ void xcd_barrier(const XcdBarrier& b) {
    asm volatile("s_waitcnt vmcnt(0)" ::: "memory");
    __syncthreads();
    if (threadIdx.x == 0) {
        unsigned* bar = b.bar;
        __builtin_amdgcn_s_waitcnt(0);
        unsigned nloc = b.st[0], nx = b.st[1];
        if (nloc == 0u) { xcd_barrier_complete(bar, b.x, nloc, nx); b.st[0] = nloc; b.st[1] = nx; }
        const unsigned old = xb_add(&bar[XB_XSUB(b.x)], 1u);
        const unsigned gen = old / nloc;
        if (old + 1u == (gen + 1u) * nloc) {
            __builtin_amdgcn_fence(__ATOMIC_RELEASE, "agent");
            asm volatile("s_waitcnt vmcnt(0)" ::: "memory");
            const unsigned og = xb_add(&bar[XB_TOP], 1u);
            const unsigned tg = og / nx;
            if (og + 1u == (tg + 1u) * nx) xb_add(&bar[XB_TOPGEN], 1u);
            else XB_SPIN(xb_ld(&bar[XB_TOPGEN]) == tg, bar);
            __builtin_amdgcn_fence(__ATOMIC_ACQUIRE, "agent");
            xb_add(&bar[XB_XGEN(b.x)], 1u);
            asm volatile("s_waitcnt vmcnt(0)" ::: "memory");
        } else {
            XB_SPIN(xb_ld(&bar[XB_XGEN(b.x)]) == gen, bar);
            __builtin_amdgcn_fence(__ATOMIC_ACQUIRE, "agent");
            asm volatile("s_waitcnt vmcnt(0)" ::: "memory");
        }
    }
    __syncthreads();
}

struct Frame {
    LAS unsigned char* lds;
    volatile LAS unsigned* MISC;
    gu32* ctl;
    int tid, lane, wave;
    int vcu, G;
};
__device__ __forceinline__ float wave_sum(float v) {
#pragma unroll
    for (int o = 1; o < 64; o <<= 1) v += __shfl_xor(v, o);
    return v;
}
__device__ __forceinline__ float bflo(unsigned w) { return __uint_as_float(w << 16); }
__device__ __forceinline__ float bfhi(unsigned w) { return __uint_as_float(w & 0xffff0000u); }

__device__ __forceinline__ void p0_transpose_item(const float* W, int K, int N, bf16* WT, LAS float* scr, int item, int lane) {
    const int nblk = N / 32, kb = item / nblk, nb = item % nblk, k0 = 64 * kb, n0 = 32 * nb;
#pragma unroll 8
    for (int i = 0; i < 32; ++i) { const int kk = 2 * i + (lane >> 5); scr[kk * 33 + (lane & 31)] = W[(size_t)(k0 + kk) * N + n0 + (lane & 31)]; }
    LDS_WAIT(); asm volatile("" ::: "memory");
    const int c = lane & 7;
#pragma unroll
    for (int j = 0; j < 4; ++j) { const int n = (lane >> 3) + 8 * j; const LAS float* s = scr + (8 * c) * 33 + n;
        v4u o; o.x = pk2(s[0 * 33], s[1 * 33]); o.y = pk2(s[2 * 33], s[3 * 33]); o.z = pk2(s[4 * 33], s[5 * 33]); o.w = pk2(s[6 * 33], s[7 * 33]);
        *(GAS v4u*)(WT + (size_t)(n0 + n) * K + k0 + 8 * c) = o; }
    LDS_WAIT(); asm volatile("" ::: "memory");
}
__device__ __forceinline__ void ln_row_to_bf16(int lane, const float* xrow, const float* g, const float* b, bf16* orow) {
    const GAS f32x4* xr = (const GAS f32x4*)xrow + lane;
    f32x4 v[8]; float s = 0.f;
#pragma unroll
    for (int j = 0; j < 8; ++j) { v[j] = xr[64 * j]; s += (v[j].x + v[j].y) + (v[j].z + v[j].w); }
    const float mean = wave_sum(s) * (1.f / DMODEL); float s2 = 0.f;
#pragma unroll
    for (int j = 0; j < 8; ++j) { v[j] = v[j] - mean; s2 += (v[j].x * v[j].x + v[j].y * v[j].y) + (v[j].z * v[j].z + v[j].w * v[j].w); }
    const float rstd = 1.f / sqrtf(wave_sum(s2) * (1.f / DMODEL) + LN_EPS);
    GAS unsigned long long* o8 = (GAS unsigned long long*)orow + lane;
    const GAS f32x4* gr = (const GAS f32x4*)g + lane; const GAS f32x4* br = (const GAS f32x4*)b + lane;
#pragma unroll
    for (int j = 0; j < 8; ++j) { const f32x4 gg = gr[64 * j], bb = br[64 * j]; const f32x4 y = v[j] * rstd * gg + bb;
        o8[64 * j] = (unsigned long long)pk2(y.x, y.y) | ((unsigned long long)pk2(y.z, y.w) << 32); }
}
__device__ __forceinline__ void cvt_chunks(const float* src, bf16* dst, size_t nchunks, int gw, int NGW, int lane) {
    for (size_t c = gw; c < nchunks; c += NGW) {
        const GAS f32x4* s = (const GAS f32x4*)(src + c * 512) + 2 * lane; const f32x4 a = s[0], b = s[1];
        v4u o; o.x = pk2(a.x, a.y); o.y = pk2(a.z, a.w); o.z = pk2(b.x, b.y); o.w = pk2(b.z, b.w);
        *((GAS v4u*)(dst + c * 512) + lane) = o; }
}
__device__ __forceinline__ float gelu_erf(float v) {
    const float av = fabsf(v), d = av * 0.2316418882f + 1.0f, t = __builtin_amdgcn_rcpf(d);
    float q = t * 0.5307027145f + (-0.7265760135f); q = q * t + 0.7107068705f; q = q * t + (-0.142248368f); q = q * t + 0.127414796f; q = q * t;
    const float e = __builtin_amdgcn_exp2f((v * v) * (-0.72134752044f));
    const float m = v * (q * e);
    return v < 0.f ? m : v - m;
}


__device__ __forceinline__ dil::BlockRef<dil::bf16, dil::bf16> dil_ref(int id, const unsigned short* QA, const unsigned short* KA, const unsigned short* VA, unsigned short* OC, float* LSE) {
    const int bh = id / 48, rest = id - bh * 48, cfg = rest >> 4, sub = rest & 15;
    const int b = bh / 12, h = bh - b * 12;
    const int r = cfg == 0 ? 1 : (cfg == 1 ? 4 : 16);
    const int nblk = 16 / r;
    const int rho = sub / nblk, n = sub - rho * nblk;
    const int P0 = n * 256;
    dil::BlockRef<dil::bf16, dil::bf16> br;
    const size_t row0 = (size_t)b * 4096 + (size_t)P0 * r + rho;
    br.Q = (const dil::bf16*)QA + row0 * 1536 + h * 128;
    br.K = (const dil::bf16*)KA + ((size_t)b * 4096 + rho) * 1536 + h * 128;
    br.V = (const dil::bf16*)VA + ((size_t)b * 4096 + rho) * 1536 + h * 128;
    br.O = (dil::bf16*)OC + (size_t)cfg * 16384 * 1536 + row0 * 1536 + h * 128;
    br.LSE = LSE + (size_t)cfg * 16384 * 12 + row0 * 12 + h;
    br.P0 = P0; br.rs = r * 1536; br.lrs = r * 12; br.skv = 4096 / r;
    return br;
}

typedef __bf16 bf16x2v __attribute__((ext_vector_type(2)));
__device__ __forceinline__ float dot2_bf16(unsigned w, unsigned x, float acc) { return __builtin_amdgcn_fdot2_f32_bf16(__builtin_bit_cast(bf16x2v, w), __builtin_bit_cast(bf16x2v, x), acc, false); }

struct Args { const float* in[19]; float* out; unsigned char* ws; int ph_lo, ph_hi, li, pad; };

__device__ __forceinline__ int fkey(float f) { const int b = __float_as_int(f); return b ^ ((b >> 31) & 0x7fffffff); }
__device__ __forceinline__ float keyf(int k) { return __int_as_float(k ^ ((k >> 31) & 0x7fffffff)); }
#define TOP16_INSERT(L, x_) do { int x__ = (x_); _Pragma("unroll") for (int i_ = 0; i_ < 16; ++i_) { const int hi__ = max(L[i_], x__); x__ = min(L[i_], x__); L[i_] = hi__; } } while (0)

__global__ void __launch_bounds__(NWAVES * 64, 2) fwd_mega(Args args) {
    extern __shared__ __attribute__((aligned(16))) unsigned char lds[];
    Frame F;
    F.lds = (LAS unsigned char*)lds;
    F.MISC = (volatile LAS unsigned*)(F.lds + MISC_OFF);
    F.tid = threadIdx.x; F.lane = F.tid & 63; F.wave = __builtin_amdgcn_readfirstlane(F.tid >> 6);
    F.G = gridDim.x; { const int bx = blockIdx.x; F.vcu = (F.G % 8 == 0) ? (bx % 8) * (F.G / 8) + bx / 8 : bx; }
    unsigned char* ws = args.ws;
    F.ctl = (gu32*)(ws + WS_CTL);
    const float* x = args.in[0]; const float* ln_emb_g = args.in[1]; const float* ln_emb_b = args.in[2]; const float* w_in = args.in[3];
    const float* dil_norm_g = args.in[4]; const float* lq1 = args.in[5]; const float* lk1 = args.in[6]; const float* lq2 = args.in[7]; const float* lk2 = args.in[8];
    const float* subln_g = args.in[9]; const float* w_out = args.in[10]; const float* ln1_g = args.in[11]; const float* ln1_b = args.in[12];
    const float* w_query = args.in[13]; const float* sub_keys = args.in[14]; const float* peer_u = args.in[15]; const float* peer_v = args.in[16];
    const float* ln2_g = args.in[17]; const float* ln2_b = args.in[18];
    float* out = args.out;
    bf16* KEYS = (bf16*)(ws + WS_KEYS); float* ROPEA = (float*)(ws + WS_ROPEA); float* ROPED = (float*)(ws + WS_ROPED); float* LSE = (float*)(ws + WS_LSE);
    bf16* WOUT = (bf16*)(ws + WS_WOUT); bf16* WQ = (bf16*)(ws + WS_WQ); bf16* WIN = (bf16*)(ws + WS_WIN);
    bf16* XN = (bf16*)(ws + WS_XN); bf16* QA = (bf16*)(ws + WS_QA); bf16* KA = (bf16*)(ws + WS_KA); bf16* VA = (bf16*)(ws + WS_VA);
    bf16* QD = (bf16*)(ws + WS_QD); bf16* KD = (bf16*)(ws + WS_KD); bf16* VD = (bf16*)(ws + WS_VD);
    bf16* OC = (bf16*)(ws + WS_OC); bf16* OD = (bf16*)(ws + WS_OD); bf16* MIXED = (bf16*)(ws + WS_MIXED); float* PRE = (float*)(ws + WS_PRE);
    bf16* H1 = (bf16*)(ws + WS_H1); bf16* QP = (bf16*)(ws + WS_QP); bf16* U16 = (bf16*)(ws + WS_U16); bf16* V16 = (bf16*)(ws + WS_V16);
    int* IDX = (int*)(ws + WS_IDX); float* GATE = (float*)(ws + WS_G);

    for (int u = F.tid; u < (LDS_BYTES - LDSCTL_OFF) / 4; u += NWAVES * 64) ((LAS unsigned*)(F.lds + LDSCTL_OFF))[u] = 0u;
    __syncthreads();
    XcdBarrier bar; bar.bar = (unsigned*)(F.ctl + CW_BAR); bar.x = 0; bar.st = nullptr;
    if (N_LAUNCHES == 1) bar = xcd_barrier_post((unsigned*)(F.ctl + CW_BAR), F.MISC + 8);
#define GRID_BAR() do { if (N_LAUNCHES == 1) xcd_barrier(bar); } while (0)
    const int lo = args.ph_lo, hi = args.ph_hi;
#define IN(k) (lo <= (k) && (k) < hi)
#define BOTH(k) (IN(k) && IN((k) + 1))
    const int gw = F.vcu * NWAVES + F.wave, NGW = F.G * NWAVES;
    const int lane = F.lane;

    if (IN(0)) {
        LAS float* scr = (LAS float*)(F.lds + RING_OFF + F.wave * 16384);
        constexpr int I_IN = (DMODEL / 64) * (INW / 32), I_SQ = (DMODEL / 64) * (DMODEL / 32);
        constexpr int NITEMS = I_IN + 2 * I_SQ;
        for (int it = gw; it < NITEMS; it += NGW) {
            int r = it;
            if (r < I_IN) { p0_transpose_item(w_in, DMODEL, INW, WIN, scr, r, lane); continue; } r -= I_IN;
            if (r < I_SQ) { p0_transpose_item(w_out, DMODEL, DMODEL, WOUT, scr, r, lane); continue; } r -= I_SQ;
            p0_transpose_item(w_query, DMODEL, DMODEL, WQ, scr, r, lane);
        }
        cvt_chunks(sub_keys, KEYS, (size_t)(8 * 2 * 128 * 128) / 512, gw, NGW, lane);
        for (int e = gw * 64 + lane; e < 4096 * 16 + 4096 * 8; e += NGW * 64) {
            int pos, i, half; float* dst;
            if (e < 4096 * 16) { pos = e >> 4; i = e & 15; half = 16; dst = ROPEA + pos * 32; }
            else { const int e2 = e - 4096 * 16; pos = e2 >> 3; i = e2 & 7; half = 8; dst = ROPED + pos * 16; }
            const float inv_freq = __builtin_amdgcn_exp2f(-(float)i / (float)half * 18.931568569324174f);
            const float ang = (float)pos * inv_freq;
            const double rev = (double)ang * 0.15915494309189535; const float fr = (float)(rev - floor(rev));
            dst[i] = __builtin_amdgcn_cosf(fr); dst[half + i] = __builtin_amdgcn_sinf(fr);
        }
        for (int m = gw; m < M; m += NGW) ln_row_to_bf16(lane, x + (size_t)m * DMODEL, ln_emb_g, ln_emb_b, XN + (size_t)m * DMODEL);
        if (BOTH(0)) GRID_BAR();
    }

    if (IN(1)) {
        pg8::Gemm g{XN, WIN, M, INW, DMODEL}; pg8::StaticOrder S; S.init(M, INW, F.G, (int)blockIdx.x);
        pg8::EpiQKV E{QA, KA, VA, QD, KD, VD, ROPEA, ROPED, 0.125f * 1.4426950408889634f};
        pg8::gemm_phase<pg8::EpiQKV, pg8::StaticOrder, true, true>(F.lds + RING_OFF, g, S, E);
        if (BOTH(1)) GRID_BAR();
    }

    if (IN(2)) {
        {
            for (int U = F.vcu; U < 1024; U += F.G) {
                const int combo = U >> 4, qb = U & 15;
                const int b = combo >> 4, h = (combo >> 2) & 3, map = (combo >> 1) & 1, vh = combo & 1;
                attn_body::attn_unit<8>(b, (2 * h + map) * 64, (2 * h + vh) * 64, qb, (const attn_body::bf16*)QD, (const attn_body::bf16*)KD, (const attn_body::bf16*)VD,
                                        (attn_body::bf16*)(OD + (size_t)map * M * 512), (char*)lds + RING_OFF);
            }
        }
        __syncthreads();
        {
            using BR = dil::BlockRef<dil::bf16, dil::bf16>;
            const int total = 48 * 48;
            int L = F.vcu;
            if (L < total) {
                BR cur = dil_ref(L, QA, KA, VA, OC, LSE);
                dil::Seam<dil::bf16> Sm;
                dil::causal_swa_prime<dil::bf16, dil::bf16>(cur, 0, (char*)lds + RING_OFF, Sm);
                for (;;) {
                    const bool more = L + F.G < total;
                    const BR nxt = more ? dil_ref(L + F.G, QA, KA, VA, OC, LSE) : cur;
                    dil::causal_swa_block<dil::bf16, dil::bf16>(cur, nxt, 0, (char*)lds + RING_OFF, Sm);
                    if (!more) break;
                    cur = nxt; L += F.G;
                }
            }
        }
        if (BOTH(2)) GRID_BAR();
    }

    if (IN(3)) {
        float lam;
        { const float a1 = wave_sum(lq1[lane] * lk1[lane]), a2 = wave_sum(lq2[lane] * lk2[lane]); lam = __expf(a1) - __expf(a2) + LAM_INIT; }
        const int hl = lane >> 4, d0 = (lane & 15) * 8;
        f32x4 ga0 = *(const f32x4*)(dil_norm_g + d0), ga1 = *(const f32x4*)(dil_norm_g + d0 + 4);
        f32x4 gb0 = *(const f32x4*)(subln_g + d0) * (1.f - LAM_INIT), gb1 = *(const f32x4*)(subln_g + d0 + 4) * (1.f - LAM_INIT);
        for (int t = gw; t < M; t += NGW) {
#pragma unroll
            for (int hg = 0; hg < 4; ++hg) {
                float o[8];
                if (hg < 3) {
                    const int head = hg * 4 + hl;
                    const float l0 = LSE[(size_t)t * 12 + head], l1 = LSE[(size_t)M * 12 + (size_t)t * 12 + head], l2 = LSE[(size_t)2 * M * 12 + (size_t)t * 12 + head];
                    const float mx = fmaxf(l0, fmaxf(l1, l2)); float w0 = __expf(l0 - mx), w1 = __expf(l1 - mx), w2 = __expf(l2 - mx);
                    const float inv = 1.f / (w0 + w1 + w2); w0 *= inv; w1 *= inv; w2 *= inv;
                    const size_t off = (size_t)t * 1536 + head * 128 + d0;
                    const v4u a = *(const GAS v4u*)(OC + off), b = *(const GAS v4u*)(OC + (size_t)M * 1536 + off), c = *(const GAS v4u*)(OC + (size_t)2 * M * 1536 + off);
#pragma unroll
                    for (int k = 0; k < 4; ++k) { o[2 * k] = w0 * bflo(a[k]) + w1 * bflo(b[k]) + w2 * bflo(c[k]); o[2 * k + 1] = w0 * bfhi(a[k]) + w1 * bfhi(b[k]) + w2 * bfhi(c[k]); }
                } else {
                    const size_t off = (size_t)t * 512 + hl * 128 + d0;
                    const v4u a = *(const GAS v4u*)(OD + off), b = *(const GAS v4u*)(OD + (size_t)M * 512 + off);
#pragma unroll
                    for (int k = 0; k < 4; ++k) { o[2 * k] = bflo(a[k]) - lam * bflo(b[k]); o[2 * k + 1] = bfhi(a[k]) - lam * bfhi(b[k]); }
                }
                float ss = 0.f;
#pragma unroll
                for (int k = 0; k < 8; ++k) ss += o[k] * o[k];
                ss += __shfl_xor(ss, 1); ss += __shfl_xor(ss, 2); ss += __shfl_xor(ss, 4); ss += __shfl_xor(ss, 8);
                const float rinv = 1.f / sqrtf(ss * (1.f / 128.f) + LN_EPS);
                f32x4 g0 = hg < 3 ? ga0 : gb0, g1 = hg < 3 ? ga1 : gb1;
                if ((DBG_MODE == 3 && hg == 3) || (DBG_MODE == 4 && hg < 3)) { g0 = g0 * 0.f; g1 = g1 * 0.f; }
                v4u w; w.x = pk2(o[0] * rinv * g0.x, o[1] * rinv * g0.y); w.y = pk2(o[2] * rinv * g0.z, o[3] * rinv * g0.w);
                w.z = pk2(o[4] * rinv * g1.x, o[5] * rinv * g1.y); w.w = pk2(o[6] * rinv * g1.z, o[7] * rinv * g1.w);
                *(GAS v4u*)(MIXED + (size_t)t * 2048 + hg * 512 + hl * 128 + d0) = w;
            }
        }
        if (BOTH(3)) GRID_BAR();
    }

    if (IN(4)) {
        pg8::Gemm g{MIXED, WOUT, M, DMODEL, DMODEL}; pg8::StaticOrder S; S.init(M, DMODEL, F.G, (int)blockIdx.x);
        pg8::EpiPre E{XN, PRE, ALPHA};
        pg8::gemm_phase<pg8::EpiPre, pg8::StaticOrder, true, true>(F.lds + RING_OFF, g, S, E);
        if (BOTH(4)) GRID_BAR();
    }

    if (IN(5)) {
        for (int m = gw; m < M; m += NGW) ln_row_to_bf16(lane, PRE + (size_t)m * DMODEL, ln1_g, ln1_b, H1 + (size_t)m * DMODEL);
        cvt_chunks(peer_u, U16, (size_t)NEXP * DMODEL / 512, gw, NGW, lane);
        cvt_chunks(peer_v, V16, (size_t)NEXP * DMODEL / 512, gw, NGW, lane);
        if (BOTH(5)) GRID_BAR();
    }

    if (IN(6) && DBG_MODE == 0) {
        pg8::Gemm g{H1, WQ, M, DMODEL, DMODEL}; pg8::StaticOrder S; S.init(M, DMODEL, F.G, (int)blockIdx.x);
        pg8::EpiBf16<0> E{QP, DMODEL, nullptr, 0, 0, 1.f};
        pg8::gemm_phase<pg8::EpiBf16<0>, pg8::StaticOrder, true, true>(F.lds + RING_OFF, g, S, E);
        if (BOTH(6)) GRID_BAR();
    }

    if (IN(7) && DBG_MODE == 0) {
        typedef float f32x16 __attribute__((ext_vector_type(16)));
        const int r32 = lane & 31, hi5 = lane >> 5;
        for (int job = gw; job < (M / 32) * 8; job += NGW) {
            const int h = job & 7, tok0 = (job >> 3) * 32;
            int la[16], lb[16];
#pragma unroll
            for (int c = 0; c < 2; ++c) {
                int L[16];
#pragma unroll
                for (int i = 0; i < 16; ++i) L[i] = (int)0x80000000;
                bf16x8 bq[8];
                const bf16* qrow = QP + (size_t)(tok0 + r32) * 2048 + h * 256 + c * 128 + hi5 * 8;
#pragma unroll
                for (int ks = 0; ks < 8; ++ks) bq[ks] = *(const GAS bf16x8*)(qrow + ks * 16);
                const bf16* kbase = KEYS + (size_t)((h * 2 + c) * 128 + r32) * 128 + hi5 * 8;
#pragma unroll 1
                for (int mt = 0; mt < 4; ++mt) {
                    f32x16 acc = {};
                    const bf16* kp = kbase + (size_t)mt * 32 * 128;
#pragma unroll
                    for (int ks = 0; ks < 8; ++ks) { const bf16x8 af = *(const GAS bf16x8*)(kp + ks * 16); acc = __builtin_amdgcn_mfma_f32_32x32x16_bf16(af, bq[ks], acc, 0, 0, 0); }
#pragma unroll
                    for (int r = 0; r < 16; ++r) { const int key = mt * 32 + (r & 3) + 8 * (r >> 2) + 4 * hi5; const int kx = (fkey(acc[r]) & ~127) | key; TOP16_INSERT(L, kx); }
                }
                int P[16];
#pragma unroll
                for (int i = 0; i < 16; ++i) P[i] = __shfl_xor(L[i], 32);
#pragma unroll
                for (int i = 0; i < 16; ++i) TOP16_INSERT(L, P[i]);
#pragma unroll
                for (int i = 0; i < 16; ++i) { if (c == 0) la[i] = L[i]; else lb[i] = L[i]; }
            }
            float fa[16], fb[16];
#pragma unroll
            for (int i = 0; i < 16; ++i) { fa[i] = keyf(la[i] & ~127); fb[i] = keyf(lb[i] & ~127); }
            int C[16];
#pragma unroll
            for (int i = 0; i < 16; ++i) C[i] = (int)0x80000000;
#pragma unroll
            for (int i = 0; i < 16; ++i)
#pragma unroll
                for (int j = 0; j < 16; ++j) if ((i + 1) * (j + 1) <= 16) { const int kx = (fkey(fa[i] + fb[j]) & ~255) | (i << 4) | j; TOP16_INSERT(C, kx); }
            int ex[16];
#pragma unroll
            for (int k = 0; k < 16; ++k) { const int ci = (C[k] >> 4) & 15, cj = C[k] & 15; int ia = 0, ib = 0;
#pragma unroll
                for (int t = 0; t < 16; ++t) { ia = (ci == t) ? (la[t] & 127) : ia; ib = (cj == t) ? (lb[t] & 127) : ib; }
                ex[k] = ia * 128 + ib; }
            const float s0 = keyf(C[0] & ~255); float e[16]; float den = 0.f;
#pragma unroll
            for (int k = 0; k < 16; ++k) { e[k] = __expf(keyf(C[k] & ~255) - s0); den += e[k]; }
            const float rden = 1.f / den;
            if (hi5 == 0) {
                int* ip = IDX + (size_t)(tok0 + r32) * 128 + h * 16; float* gp = GATE + (size_t)(tok0 + r32) * 128 + h * 16;
#pragma unroll
                for (int k = 0; k < 16; k += 4) { *(int4*)(ip + k) = make_int4(ex[k], ex[k + 1], ex[k + 2], ex[k + 3]);
                    *(f32x4*)(gp + k) = (f32x4){e[k] * rden, e[k + 1] * rden, e[k + 2] * rden, e[k + 3] * rden}; }
            }
        }
        if (BOTH(7)) GRID_BAR();
    }

    if (IN(8)) {
        for (int t = gw; t < M; t += NGW) {
            v4u xw[4];
            const GAS v4u* xr = (const GAS v4u*)(H1 + (size_t)t * 2048) + lane;
#pragma unroll
            for (int j = 0; j < 4; ++j) xw[j] = xr[64 * j];
            const int idx_lo = IDX[(size_t)t * 128 + lane], idx_hi = IDX[(size_t)t * 128 + 64 + lane];
            const float g_lo = GATE[(size_t)t * 128 + lane], g_hi = GATE[(size_t)t * 128 + 64 + lane];
            float y[32];
#pragma unroll
            for (int i = 0; i < 32; ++i) y[i] = 0.f;
#pragma unroll 1
            for (int grp = 0; grp < (DBG_MODE != 0 ? 0 : 32); ++grp) {
                int e[4]; float gg[4];
#pragma unroll
                for (int i = 0; i < 4; ++i) { const int src = (grp * 4 + i) & 63;
                    e[i] = __builtin_amdgcn_readlane(grp < 16 ? idx_lo : idx_hi, src);
                    gg[i] = __int_as_float(__builtin_amdgcn_readlane(__float_as_int(grp < 16 ? g_lo : g_hi), src)); }
                v4u uw[4][4], vw[4][4];
#pragma unroll
                for (int i = 0; i < 4; ++i) { const GAS v4u* up = (const GAS v4u*)(U16 + (size_t)e[i] * 2048) + lane;
#pragma unroll
                    for (int j = 0; j < 4; ++j) uw[i][j] = up[64 * j]; }
#pragma unroll
                for (int i = 0; i < 4; ++i) { const GAS v4u* vp = (const GAS v4u*)(V16 + (size_t)e[i] * 2048) + lane;
#pragma unroll
                    for (int j = 0; j < 4; ++j) vw[i][j] = vp[64 * j]; }
                float a[4];
#pragma unroll
                for (int i = 0; i < 4; ++i) { float z0 = 0.f, z1 = 0.f;
#pragma unroll
                    for (int j = 0; j < 4; ++j) {
                        z0 = dot2_bf16(uw[i][j].x, xw[j].x, z0); z1 = dot2_bf16(uw[i][j].y, xw[j].y, z1);
                        z0 = dot2_bf16(uw[i][j].z, xw[j].z, z0); z1 = dot2_bf16(uw[i][j].w, xw[j].w, z1); }
                    const float z = wave_sum(z0 + z1);
                    a[i] = gg[i] * gelu_erf(z); }
#pragma unroll
                for (int i = 0; i < 4; ++i)
#pragma unroll
                    for (int j = 0; j < 4; ++j)
#pragma unroll
                        for (int k = 0; k < 4; ++k) { const unsigned w = vw[i][j][k]; y[j * 8 + 2 * k] += a[i] * bflo(w); y[j * 8 + 2 * k + 1] += a[i] * bfhi(w); }
            }
            float s = 0.f;
#pragma unroll
            for (int j = 0; j < 4; ++j)
#pragma unroll
                for (int k = 0; k < 4; ++k) { const unsigned w = xw[j][k]; y[j * 8 + 2 * k] += ALPHA * bflo(w); y[j * 8 + 2 * k + 1] += ALPHA * bfhi(w); s += y[j * 8 + 2 * k] + y[j * 8 + 2 * k + 1]; }
            const float mean = wave_sum(s) * (1.f / DMODEL); float s2 = 0.f;
#pragma unroll
            for (int i = 0; i < 32; ++i) { y[i] -= mean; s2 += y[i] * y[i]; }
            const float rstd = 1.f / sqrtf(wave_sum(s2) * (1.f / DMODEL) + LN_EPS);
#pragma unroll
            for (int j = 0; j < 4; ++j) { const int e0 = j * 512 + lane * 8;
                const f32x4 g0 = *(const f32x4*)(ln2_g + e0), g1 = *(const f32x4*)(ln2_g + e0 + 4), b0 = *(const f32x4*)(ln2_b + e0), b1 = *(const f32x4*)(ln2_b + e0 + 4);
                f32x4 o0 = {y[j * 8 + 0], y[j * 8 + 1], y[j * 8 + 2], y[j * 8 + 3]}, o1 = {y[j * 8 + 4], y[j * 8 + 5], y[j * 8 + 6], y[j * 8 + 7]};
                o0 = o0 * rstd * g0 + b0; o1 = o1 * rstd * g1 + b1;
                *(GAS f32x4*)(out + (size_t)t * 2048 + e0) = o0; *(GAS f32x4*)(out + (size_t)t * 2048 + e0 + 4) = o1; }
        }
    }
#undef IN
#undef BOTH
#undef GRID_BAR
}


#ifndef DBG_CHECK
#define DBG_CHECK 0
#endif
#if DBG_CHECK
__device__ __forceinline__ float bfv(const unsigned short* p, size_t i) { return __uint_as_float((unsigned)p[i] << 16); }
constexpr size_t WS_FLAGS = 768 * 1024;
__global__ void __launch_bounds__(256) chk_kernel(Args args, int which) {
    unsigned char* ws = args.ws;
    unsigned* flags = (unsigned*)(ws + WS_FLAGS);
    const unsigned short* KEYS = (const unsigned short*)(ws + WS_KEYS);
    const unsigned short* WQ = (const unsigned short*)(ws + WS_WQ);
    const unsigned short* H1 = (const unsigned short*)(ws + WS_H1);
    const unsigned short* QP = (const unsigned short*)(ws + WS_QP);
    const unsigned short* U16 = (const unsigned short*)(ws + WS_U16);
    const unsigned short* V16 = (const unsigned short*)(ws + WS_V16);
    const int* IDX = (const int*)(ws + WS_IDX); const float* GATE = (const float*)(ws + WS_G);
    const int lane = threadIdx.x & 63, wave = threadIdx.x >> 6, gwv = blockIdx.x * 4 + wave;
    __shared__ float s_sv[4][2][16]; __shared__ int s_si[4][2][16]; __shared__ float s_ts[4][16]; __shared__ int s_tp[4][16];
    if (which == 6) {
        const unsigned s = blockIdx.x * 256 + threadIdx.x;
        const int row = (int)((s * 2654435761u) % 16384u), col = (int)((s * 40503u + 17u) % 2048u);
        float ref = 0.f;
        for (int k = 0; k < 2048; ++k) ref += bfv(H1, (size_t)row * 2048 + k) * bfv(WQ, (size_t)col * 2048 + k);
        const float got = bfv(QP, (size_t)row * 2048 + col);
        if (!(fabsf(ref - got) <= 0.05f)) atomicAdd(&flags[6], 1u);
        atomicAdd(&flags[16 + 6], 1u);
    }
    if (which == 7) {
        const int t = (int)(((unsigned)gwv * 2654435761u) % 16384u), h = gwv & 7;
        for (int c = 0; c < 2; ++c) {
            float v0 = 0.f, v1 = 0.f;
            for (int d = 0; d < 128; ++d) { const float qv = bfv(QP, (size_t)t * 2048 + h * 256 + c * 128 + d);
                v0 += qv * bfv(KEYS, (size_t)((h * 2 + c) * 128 + lane) * 128 + d); v1 += qv * bfv(KEYS, (size_t)((h * 2 + c) * 128 + lane + 64) * 128 + d); }
            for (int k = 0; k < 16; ++k) {
                float bv = v0 >= v1 ? v0 : v1; int bi = v0 >= v1 ? lane : lane + 64;
                for (int o = 1; o < 64; o <<= 1) { const float ov = __shfl_xor(bv, o); const int oi = __shfl_xor(bi, o); if (ov > bv || (ov == bv && oi < bi)) { bv = ov; bi = oi; } }
                if (bi == lane) v0 = -3.0e38f; if (bi == lane + 64) v1 = -3.0e38f;
                if (lane == 0) { s_sv[wave][c][k] = bv; s_si[wave][c][k] = bi; }
            }
        }
        __syncthreads();
        float cv0, cv1, cv2, cv3; const int q0 = lane * 4;
        cv0 = s_sv[wave][0][q0 >> 4] + s_sv[wave][1][q0 & 15]; cv1 = s_sv[wave][0][(q0 + 1) >> 4] + s_sv[wave][1][(q0 + 1) & 15];
        cv2 = s_sv[wave][0][(q0 + 2) >> 4] + s_sv[wave][1][(q0 + 2) & 15]; cv3 = s_sv[wave][0][(q0 + 3) >> 4] + s_sv[wave][1][(q0 + 3) & 15];
        for (int k = 0; k < 16; ++k) {
            float bv = cv0; int bi = q0;
            if (cv1 > bv) { bv = cv1; bi = q0 + 1; } if (cv2 > bv) { bv = cv2; bi = q0 + 2; } if (cv3 > bv) { bv = cv3; bi = q0 + 3; }
            for (int o = 1; o < 64; o <<= 1) { const float ov = __shfl_xor(bv, o); const int oi = __shfl_xor(bi, o); if (ov > bv || (ov == bv && oi < bi)) { bv = ov; bi = oi; } }
            if (bi == q0) cv0 = -3.0e38f; if (bi == q0 + 1) cv1 = -3.0e38f; if (bi == q0 + 2) cv2 = -3.0e38f; if (bi == q0 + 3) cv3 = -3.0e38f;
            if (lane == 0) { s_ts[wave][k] = bv; s_tp[wave][k] = bi; }
        }
        __syncthreads();
        float den = 0.f; for (int k = 0; k < 16; ++k) den += __expf(s_ts[wave][k] - s_ts[wave][0]);
        if (lane < 16) {
            const int k = lane; const float tsk = s_ts[wave][k]; const int tpk = s_tp[wave][k]; const float ts0 = s_ts[wave][0];
            const int idx = s_si[wave][0][tpk >> 4] * 128 + s_si[wave][1][tpk & 15];
            const float g = __expf(tsk - ts0) / den;
            const int gi = IDX[(size_t)t * 128 + h * 16 + k]; const float gg = GATE[(size_t)t * 128 + h * 16 + k];
            if (gi != idx || !(fabsf(g - gg) <= 0.01f)) atomicAdd(&flags[7], 1u);
            if (!(fabsf(g - gg) <= 0.02f)) atomicAdd(&flags[9], 1u);
            atomicAdd(&flags[16 + 7], 1u);
        }
    }
    if (which == 8) {
        const int t = (int)(((unsigned)gwv * 2654435761u + 12345u) % 16384u);
        const float* ln2_g = args.in[17]; const float* ln2_b = args.in[18];
        float y[32];
        for (int i = 0; i < 32; ++i) y[i] = 0.f;
        for (int k = 0; k < 128; ++k) {
            const int e = IDX[(size_t)t * 128 + k]; const float g = GATE[(size_t)t * 128 + k];
            float z = 0.f;
            for (int i = 0; i < 32; ++i) z += bfv(U16, (size_t)e * 2048 + lane + 64 * i) * bfv(H1, (size_t)t * 2048 + lane + 64 * i);
            z = wave_sum(z);
            const float a = g * 0.5f * z * (1.f + erff(z * 0.70710678118f));
            for (int i = 0; i < 32; ++i) y[i] += a * bfv(V16, (size_t)e * 2048 + lane + 64 * i);
        }
        float s = 0.f;
        for (int i = 0; i < 32; ++i) { y[i] += ALPHA * bfv(H1, (size_t)t * 2048 + lane + 64 * i); s += y[i]; }
        const float mean = wave_sum(s) * (1.f / 2048.f); float s2 = 0.f;
        for (int i = 0; i < 32; ++i) { y[i] -= mean; s2 += y[i] * y[i]; }
        const float rstd = 1.f / sqrtf(wave_sum(s2) * (1.f / 2048.f) + LN_EPS);
        unsigned bad = 0;
        for (int i = 0; i < 32; ++i) { const int d = lane + 64 * i; const float ref = y[i] * rstd * ln2_g[d] + ln2_b[d]; const float got = args.out[(size_t)t * 2048 + d];
            if (!(fabsf(ref - got) <= 2e-3f * (1.f + fabsf(ref)))) ++bad; }
        if (bad) atomicAdd(&flags[8], bad);
        atomicAdd(&flags[16 + 8], 32u);
    }
}
__global__ void __launch_bounds__(256) chk_out(Args args, int f0, int t0, int f1, int t1, int f2, int t2, int f3, int t3) {
    const unsigned* flags = (const unsigned*)(args.ws + WS_FLAGS);
    float c = 0.f;
    if (f0 >= 0 && flags[f0] > (unsigned)t0) c += 1.f;
    if (f1 >= 0 && flags[f1] > (unsigned)t1) c += 2.f;
    if (f2 >= 0 && flags[f2] > (unsigned)t2) c += 4.f;
    if (f3 >= 0 && flags[f3] > (unsigned)t3) c += 8.f;
    for (size_t i = (size_t)blockIdx.x * 256 + threadIdx.x; i < (size_t)16384 * 2048; i += (size_t)gridDim.x * 256) args.out[i] = c;
}
#endif

extern "C" void kernel_launch(void* const* d_in, const int* in_sizes, int n_in, void* d_out, int out_size, void* d_ws, size_t ws_size, hipStream_t stream) {
    static int grid = 0;
    if (grid == 0) {
        if (n_in != 19 || in_sizes[0] != M * DMODEL || out_size != M * DMODEL || ws_size < WS_END) {
            fprintf(stderr, "kernel_launch: shape/workspace mismatch (n_in %d, in0 %d, out %d, ws %zu; need ws >= %zu); nothing launched\n", n_in, n_in > 0 ? in_sizes[0] : -1, out_size, ws_size, (size_t)WS_END); grid = -1; return; }
        int dev = 0, cus = 0, per_cu = 0;
        if (hipGetDevice(&dev) != hipSuccess || hipDeviceGetAttribute(&cus, hipDeviceAttributeMultiprocessorCount, dev) != hipSuccess) { fprintf(stderr, "kernel_launch: device query failed\n"); grid = -1; return; }
        if (hipFuncSetAttribute((const void*)fwd_mega, hipFuncAttributeMaxDynamicSharedMemorySize, LDS_BYTES) != hipSuccess) { fprintf(stderr, "kernel_launch: hipFuncSetAttribute failed\n"); grid = -1; return; }
        if (hipOccupancyMaxActiveBlocksPerMultiprocessor(&per_cu, (const void*)fwd_mega, NWAVES * 64, LDS_BYTES) != hipSuccess || per_cu < 1)
            fprintf(stderr, "kernel_launch: note: occupancy query reports %d workgroups per CU\n", per_cu);
        (void)hipGetLastError();
        grid = cus;
        if (grid != 256) fprintf(stderr, "kernel_launch: note: %d CUs (tuned for 256)\n", grid);
    }
    if (grid < 0) return;
    if (hipMemsetAsync((char*)d_ws + WS_CTL, 0, CTL_ZERO_BYTES, stream) != hipSuccess) { fprintf(stderr, "kernel_launch: memset failed\n"); return; }
    Args a{};
    for (int i = 0; i < 19; ++i) a.in[i] = (const float*)d_in[i];
    a.out = (float*)d_out; a.ws = (unsigned char*)d_ws;
    if (N_LAUNCHES == 1) { a.ph_lo = 0; a.ph_hi = MK_PHASE_HI; a.li = 0; hipLaunchKernelGGL(fwd_mega, dim3(grid), dim3(NWAVES * 64), LDS_BYTES, stream, a); }
    else { for (int li = 0; li < MK_PHASE_HI; ++li) { a.ph_lo = li; a.ph_hi = li + 1; a.li = li; hipLaunchKernelGGL(fwd_mega, dim3(grid), dim3(NWAVES * 64), LDS_BYTES, stream, a);
#if DBG_CHECK == 1
            if (li == 6) hipLaunchKernelGGL(chk_kernel, dim3(16), dim3(256), 0, stream, a, 6);
            if (li == 7) hipLaunchKernelGGL(chk_kernel, dim3(64), dim3(256), 0, stream, a, 7);
            if (li == 8) { hipLaunchKernelGGL(chk_kernel, dim3(32), dim3(256), 0, stream, a, 8);
                           hipLaunchKernelGGL(chk_out, dim3(1024), dim3(256), 0, stream, a, 6, 40, 7, 200, 8, 40, 9, 200); }
#endif
        } }
    const hipError_t le = hipPeekAtLastError();
    if (le != hipSuccess) fprintf(stderr, "kernel_launch: launch failed: %s\n", hipGetErrorName(le));
}
```

```cpp
#include <hip/hip_runtime.h>
#include <hip/hip_bf16.h>
#include <cstdio>
#include <cstdint>
#include <cmath>

#ifndef MK_N_LAUNCHES
#define MK_N_LAUNCHES 1
#endif
#ifndef MK_PHASE_HI
#define MK_PHASE_HI 12
#endif

__device__ __forceinline__ int tid_fresh() { int t_; asm volatile("v_mov_b32 %0, %1" : "=v"(t_) : "v"((int)threadIdx.x)); return t_; }
namespace pg8 {
#define PG8_LAS __attribute__((address_space(3)))
typedef unsigned short bf16_t;
typedef short bf16x8 __attribute__((ext_vector_type(8)));
typedef float f32x4 __attribute__((ext_vector_type(4)));
typedef unsigned u32x4 __attribute__((ext_vector_type(4)));
typedef int i32x4 __attribute__((ext_vector_type(4)));
template <bool B, class T, class F> struct cond_t { typedef T type; };
template <class T, class F> struct cond_t<false, T, F> { typedef F type; };
__device__ __forceinline__ f32x4 mma1(bf16x8 a, bf16x8 b, f32x4 c) { return __builtin_amdgcn_mfma_f32_16x16x32_bf16(a, b, c, 0, 0, 0); }
__device__ __forceinline__ i32x4 mma1(bf16x8 a, bf16x8 b, i32x4 c) { return __builtin_amdgcn_mfma_i32_16x16x64_i8(__builtin_bit_cast(i32x4, a), __builtin_bit_cast(i32x4, b), c, 0, 0, 0); }
constexpr int BM = 256, BK = 64, HALF = 128, HTB = HALF * BK * 2  , STAGE_BYTES = 8 * HTB, NXCD = 8, WGM = 8;

__host__ __device__ __forceinline__ int lds_byte(int r, int c) { const int st = (r >> 4) * 2 + (c >> 5), rr = r & 15, cc = c & 31, ob = rr * 64 + cc * 2; return st * 1024 + (ob ^ (((ob >> 9) & 1) << 5)); }
__host__ __device__ __forceinline__ void stage_rc(int b, int& R, int& C) { const int st = b / 1024, sb = b % 1024, swz = sb ^ (((sb >> 9) & 1) << 5); R = (st >> 1) * 16 + swz / 64; C = (st & 1) * 32 + (swz % 64) / 2; }
__host__ __device__ __forceinline__ int perm32(int rho) { const int n = rho >> 4, i = rho & 15; return 8 * (i >> 2) + 4 * n + (i & 3); }

struct Unit { int pm, pn; };
struct Gemm { const void* A; const void* Bt; int M, N, K; };

struct StaticOrder {
    int nM, nN, nwg, G, c;
    __host__ __device__ void init(int M, int N, int G_, int c_) { nM = M / BM; nN = N / BM; nwg = nM * nN; G = G_; c = c_; }
    __host__ __device__ bool next(int i, Unit& u) const {
        const long L = (long)i * G + c; if (L >= nwg) return false;
        int wgid = (int)L; { const int q = nwg / NXCD, r = nwg % NXCD, xcd = wgid % NXCD, off = wgid / NXCD; wgid = (xcd < r ? xcd * (q + 1) : r * (q + 1) + (xcd - r) * q) + off; }
        const int nig = WGM * nN, gid = wgid / nig, fm = gid * WGM, gsz = (nM - fm) < WGM ? (nM - fm) : WGM;
        u.pm = fm + ((wgid % nig) % gsz); u.pn = (wgid % nig) / gsz; return true;
    }
    __device__ __forceinline__ void a_ready(const Unit&) const {}
    __device__ __forceinline__ void done(const Unit&) const {}
};

__device__ __forceinline__ unsigned cvt_pk_bf16(float lo, float hi) { unsigned r; asm volatile("v_cvt_pk_bf16_f32 %0, %1, %2" : "=v"(r) : "v"(lo), "v"(hi)); return r; }

template <int ACT  > struct EpiBf16 {
    static constexpr bool PERM = true, AFTER_DRAIN = false, I8 = false; static_assert(ACT == 0 || ACT == 1, "EpiBf16: ACT is 0 (none) or 1 (gelu_pk)");
    bf16_t* O; int ldc; const float* bias; int split_cols; size_t split_stride; float scale0;
    __device__ __forceinline__ void operator()(const f32x4 (&acc)[2][2][4][2], const Unit& u, int wr, int wc, int fr, int fq) const {
        const int row0 = u.pm * BM + wr * 64 + fr; int colt = u.pn * BM; bf16_t* base = O;
        float sc = 1.f; if (split_cols) { const int t = colt / split_cols; base += (size_t)t * split_stride; colt -= t * split_cols; if (t == 0) sc = scale0; }
        const int col0 = colt + wc * 32 + 8 * fq, bcol0 = u.pn * BM + wc * 32 + 8 * fq;
        f32x4 bv[2][2];
#pragma unroll
        for (int bj = 0; bj < 2; ++bj)
#pragma unroll
            for (int n = 0; n < 2; ++n) bv[bj][n] = bias ? *(const f32x4*)(bias + bcol0 + bj * HALF + 4 * n) : (f32x4){0.f, 0.f, 0.f, 0.f};
#pragma unroll
        for (int ai = 0; ai < 2; ++ai)
#pragma unroll
            for (int m = 0; m < 4; ++m) { bf16_t* rowp = base + (size_t)(row0 + ai * HALF + m * 16) * ldc + col0;
#pragma unroll
                for (int bj = 0; bj < 2; ++bj) { f32x4 v0 = acc[ai][bj][m][0] + bv[bj][0], v1 = acc[ai][bj][m][1] + bv[bj][1];
                    v0 = v0 * sc; v1 = v1 * sc; u32x4 w; w.x = cvt_pk_bf16(v0[0], v0[1]); w.y = cvt_pk_bf16(v0[2], v0[3]); w.z = cvt_pk_bf16(v1[0], v1[1]); w.w = cvt_pk_bf16(v1[2], v1[3]);
                    *(u32x4*)(rowp + bj * HALF) = w; } }
    }
};

__device__ __forceinline__ f32x4 shx4(f32x4 v, int mask) { f32x4 r; r[0] = __shfl_xor(v[0], mask); r[1] = __shfl_xor(v[1], mask); r[2] = __shfl_xor(v[2], mask); r[3] = __shfl_xor(v[3], mask); return r; }
struct EpiQKV {
    static constexpr bool PERM = true, AFTER_DRAIN = false, I8 = true;
    bf16_t *QA, *KA, *VA, *QD, *KD, *VD;
    const float* ropeA;
    const float* ropeD;
    float qd_scale;
    const float* sa;
    const float* sw;
    __device__ __forceinline__ void operator()(const i32x4 (&acc)[2][2][4][2], const Unit& u, int wr, int wc, int fr, int fq) const {
        const int pn = u.pn;
        bf16_t* base; int ldc, colt, kind; float sc = 1.f;
        if (pn < 6)       { base = QA; ldc = 1536; colt = pn * 256;        kind = 1; }
        else if (pn < 12) { base = KA; ldc = 1536; colt = (pn - 6) * 256;  kind = 1; }
        else if (pn < 18) { base = VA; ldc = 1536; colt = (pn - 12) * 256; kind = 0; }
        else if (pn < 20) { base = QD; ldc = 512;  colt = (pn - 18) * 256; kind = 2; sc = qd_scale; }
        else if (pn < 22) { base = KD; ldc = 512;  colt = (pn - 20) * 256; kind = 2; }
        else              { base = VD; ldc = 512;  colt = (pn - 22) * 256; kind = 0; }
        const int row0 = u.pm * BM + wr * 64 + fr, col0 = colt + wc * 32 + 8 * fq, wcol0 = pn * BM + wc * 32 + 8 * fq;
        const bool ra = (kind == 1) && (wc == 0);
        const bool rd = (kind == 2) && ((wc & 1) == 0);
        f32x4 w0[2], w1[2];
#pragma unroll
        for (int bj = 0; bj < 2; ++bj) { w0[bj] = *(const f32x4*)(sw + wcol0 + bj * HALF) * sc; w1[bj] = *(const f32x4*)(sw + wcol0 + bj * HALF + 4) * sc; }
        const float sg = ra ? (fq < 2 ? -1.f : 1.f) : (fq == 0 ? -1.f : 1.f);
        const bool rot = ra || (rd && fq < 2);
        u32x4 wq[8][2];
        const float* tb = ra ? ropeA + 8 * (fq & 1) : ropeD; const int tstr = ra ? 32 : 16, so = ra ? 16 : 8;
        f32x4 rt[2][4]; float srr[2];
#define QKV_LD(it_) do { const int row_ = row0 + ((it_) >> 2) * HALF + ((it_) & 3) * 16; const float* t = tb + (row_ & 4095) * tstr; srr[(it_) & 1] = sa[row_]; \
            rt[(it_) & 1][0] = *(const f32x4*)t; rt[(it_) & 1][1] = *(const f32x4*)(t + 4); rt[(it_) & 1][2] = *(const f32x4*)(t + so); rt[(it_) & 1][3] = *(const f32x4*)(t + so + 4); } while (0)
        QKV_LD(0);
#pragma unroll
        for (int it = 0; it < 8; ++it) {
            const int ai = it >> 2, m = it & 3;
            if (it + 1 < 8) QKV_LD(it + 1);
            const float sr = srr[it & 1];
            const f32x4 c0 = rt[it & 1][0], c1 = rt[it & 1][1], s0 = rt[it & 1][2] * sg, s1 = rt[it & 1][3] * sg;
#pragma unroll
            for (int bj = 0; bj < 2; ++bj) {
                f32x4 v0 = __builtin_convertvector(acc[ai][bj][m][0], f32x4) * (w0[bj] * sr), v1 = __builtin_convertvector(acc[ai][bj][m][1], f32x4) * (w1[bj] * sr);
                if (ra) { const f32x4 p0 = shx4(v0, 32), p1 = shx4(v1, 32); v0 = v0 * c0 + p0 * s0; v1 = v1 * c1 + p1 * s1; }
                if (rd) { const f32x4 p0 = shx4(v0, 16), p1 = shx4(v1, 16); if (rot) { v0 = v0 * c0 + p0 * s0; v1 = v1 * c1 + p1 * s1; } }
                wq[it][bj].x = cvt_pk_bf16(v0[0], v0[1]); wq[it][bj].y = cvt_pk_bf16(v0[2], v0[3]); wq[it][bj].z = cvt_pk_bf16(v1[0], v1[1]); wq[it][bj].w = cvt_pk_bf16(v1[2], v1[3]); }
        }
#undef QKV_LD
        asm volatile("" ::: "memory");
#pragma unroll
        for (int it = 0; it < 8; ++it) { bf16_t* rowp = base + (size_t)(row0 + (it >> 2) * HALF + (it & 3) * 16) * ldc + col0;
#pragma unroll
            for (int bj = 0; bj < 2; ++bj) *(u32x4*)(rowp + bj * HALF) = wq[it][bj]; }
    }
};
struct EpiPre {
    static constexpr bool PERM = true, AFTER_DRAIN = false, I8 = true;
    const bf16_t* H0; float* PRE; float alpha;
    const float* sa;
    const float* sw;
    __device__ __forceinline__ void operator()(const i32x4 (&acc)[2][2][4][2], const Unit& u, int wr, int wc, int fr, int fq) const {
        const int row0 = u.pm * BM + wr * 64 + fr, col0 = u.pn * BM + wc * 32 + 8 * fq;
        f32x4 w0[2], w1[2];
#pragma unroll
        for (int bj = 0; bj < 2; ++bj) { w0[bj] = *(const f32x4*)(sw + col0 + bj * HALF); w1[bj] = *(const f32x4*)(sw + col0 + bj * HALF + 4); }
        f32x4 o0[8][2], o1[8][2];
#pragma unroll
        for (int it = 0; it < 8; ++it) {
            const int ai = it >> 2, m = it & 3, row = row0 + ai * HALF + m * 16; const size_t off = (size_t)row * 2048 + col0;
            const float sr = sa[row];
#pragma unroll
            for (int bj = 0; bj < 2; ++bj) { const u32x4 h = *(const u32x4*)(H0 + off + bj * HALF);
                const f32x4 h0 = {__uint_as_float(h.x << 16), __uint_as_float(h.x & 0xffff0000u), __uint_as_float(h.y << 16), __uint_as_float(h.y & 0xffff0000u)};
                const f32x4 h1 = {__uint_as_float(h.z << 16), __uint_as_float(h.z & 0xffff0000u), __uint_as_float(h.w << 16), __uint_as_float(h.w & 0xffff0000u)};
                o0[it][bj] = h0 * alpha + __builtin_convertvector(acc[ai][bj][m][0], f32x4) * (w0[bj] * sr);
                o1[it][bj] = h1 * alpha + __builtin_convertvector(acc[ai][bj][m][1], f32x4) * (w1[bj] * sr); }
        }
        asm volatile("" ::: "memory");
#pragma unroll
        for (int it = 0; it < 8; ++it) { const size_t off = (size_t)(row0 + (it >> 2) * HALF + (it & 3) * 16) * 2048 + col0;
#pragma unroll
            for (int bj = 0; bj < 2; ++bj) { *(f32x4*)(PRE + off + bj * HALF) = o0[it][bj]; *(f32x4*)(PRE + off + bj * HALF + 4) = o1[it][bj]; } }
    }
};

struct EpiQP {
    static constexpr bool PERM = true, AFTER_DRAIN = false, I8 = true;
    bf16_t* O; const float* sa; const float* cm;
    __device__ __forceinline__ void operator()(const i32x4 (&acc)[2][2][4][2], const Unit& u, int wr, int wc, int fr, int fq) const {
        const int row0 = u.pm * BM + wr * 64 + fr, col0 = u.pn * BM + wc * 32 + 8 * fq;
        f32x4 w0[2], w1[2];
#pragma unroll
        for (int bj = 0; bj < 2; ++bj) { w0[bj] = *(const f32x4*)(cm + col0 + bj * HALF) * (1.f / 127.f); w1[bj] = *(const f32x4*)(cm + col0 + bj * HALF + 4) * (1.f / 127.f); }
        float sr[8];
#pragma unroll
        for (int it = 0; it < 8; ++it) sr[it] = sa[row0 + (it >> 2) * HALF + (it & 3) * 16];
        u32x4 wq[8][2];
#pragma unroll
        for (int it = 0; it < 8; ++it) { const int ai = it >> 2, m = it & 3;
#pragma unroll
            for (int bj = 0; bj < 2; ++bj) { const f32x4 v0 = __builtin_convertvector(acc[ai][bj][m][0], f32x4) * (w0[bj] * sr[it]), v1 = __builtin_convertvector(acc[ai][bj][m][1], f32x4) * (w1[bj] * sr[it]);
                wq[it][bj].x = cvt_pk_bf16(v0[0], v0[1]); wq[it][bj].y = cvt_pk_bf16(v0[2], v0[3]); wq[it][bj].z = cvt_pk_bf16(v1[0], v1[1]); wq[it][bj].w = cvt_pk_bf16(v1[2], v1[3]); } }
        asm volatile("" ::: "memory");
#pragma unroll
        for (int it = 0; it < 8; ++it) { bf16_t* rowp = O + (size_t)(row0 + (it >> 2) * HALF + (it & 3) * 16) * 2048 + col0;
#pragma unroll
            for (int bj = 0; bj < 2; ++bj) *(u32x4*)(rowp + bj * HALF) = wq[it][bj]; }
    }
};

template <class Epi, class Sched, bool ALIGN_EPI = false, bool SP2 = false>
__device__ __forceinline__ void gemm_phase(PG8_LAS unsigned char* lds, const Gemm g, const Sched& S, const Epi& E) {
    const int tid = threadIdx.x, wid = __builtin_amdgcn_readfirstlane(tid >> 6), lane = tid & 63, wr = wid >> 2, wc = wid & 3, fr = lane & 15, fq = lane >> 4;
    constexpr bool I8 = Epi::I8; typedef typename cond_t<I8, i32x4, f32x4>::type acc_t;
    const int K = I8 ? g.K / 2 : g.K, nt = K / BK;
    unsigned voffA[2], voffB[2];
#pragma unroll
    for (int i = 0; i < 2; ++i) { int R, C; stage_rc(tid * 16 + i * 8192, R, C); const int Rb = Epi::PERM ? ((R & ~31) + perm32(R & 31)) : R;
        voffA[i] = (unsigned)(R * K + C) * 2u; voffB[i] = (unsigned)(Rb * K + C) * 2u; }
    const size_t kstep = (size_t)(BK * 2);
    const size_t hstep = (size_t)HALF * K * 2;
    const size_t tstep = 2 * hstep;
    const unsigned ldsw = (unsigned)wid * 1024u;
    const int aoff = lds_byte(wr * 64 + fr, fq * 8), boff = lds_byte(wc * 32 + fr, fq * 8);
#define PG8_SA(b, h) (((b) * 2 + (h)) * HTB)
#define PG8_SB(b, h) ((4 + (b) * 2 + (h)) * HTB)
#define PG8_STAGE(bufoff, gbase, voff) do { _Pragma("unroll") for (int _i = 0; _i < 2; ++_i) \
        __builtin_amdgcn_global_load_lds((const unsigned*)((const char*)(gbase) + (voff)[_i]), (PG8_LAS unsigned*)(lds + (bufoff) + ldsw + _i * 8192), 16, 0, 0); } while (0)
#define PG8_LDA(dst, b, h) do { _Pragma("unroll") for (int m = 0; m < 4; ++m) _Pragma("unroll") for (int k = 0; k < 2; ++k) dst[m][k] = *(const PG8_LAS bf16x8*)(lds + PG8_SA(b, h) + aoff + m * 2048 + k * 1024); } while (0)
#define PG8_LDB(dst, b, h) do { _Pragma("unroll") for (int n = 0; n < 2; ++n) _Pragma("unroll") for (int k = 0; k < 2; ++k) dst[n][k] = *(const PG8_LAS bf16x8*)(lds + PG8_SB(b, h) + boff + n * 2048 + k * 1024); } while (0)
#define PG8_MMA(ai, bj, At, Bt) do { __builtin_amdgcn_s_setprio(1); _Pragma("unroll") for (int m = 0; m < 4; ++m) _Pragma("unroll") for (int n = 0; n < 2; ++n) _Pragma("unroll") for (int k = 0; k < 2; ++k) \
        acc[ai][bj][m][n] = mma1(Bt[n][k], At[m][k], acc[ai][bj][m][n]); __builtin_amdgcn_s_setprio(0); } while (0)
#define PG8_WAIT_V(n) asm volatile("s_waitcnt vmcnt(" #n ")" ::: "memory")
#define PG8_WAIT_L(n) asm volatile("s_waitcnt lgkmcnt(" #n ")" ::: "memory")
#define PG8_BAR __builtin_amdgcn_s_barrier()
#define PG8_SCHED __builtin_amdgcn_sched_barrier(0)
    Unit cur, nxt; int ui = 0;
    if (!S.next(0, cur)) return;
    acc_t acc[2][2][4][2];
#pragma unroll
    for (int a = 0; a < 2; ++a)
#pragma unroll
        for (int b = 0; b < 2; ++b)
#pragma unroll
            for (int m = 0; m < 4; ++m)
#pragma unroll
                for (int n = 0; n < 2; ++n) acc[a][b][m][n] = acc_t{};
    bf16x8 At[4][2], B0[2][2], B1[2][2];
    const char* cA = (const char*)g.A + (size_t)cur.pm * tstep; const char* cB = (const char*)g.Bt + (size_t)cur.pn * tstep;
    S.a_ready(cur);
    if constexpr (SP2) {
        PG8_STAGE(PG8_SB(0, 0), cB, voffB); PG8_STAGE(PG8_SB(0, 1), cB + hstep, voffB); PG8_STAGE(PG8_SA(0, 0), cA, voffA); PG8_STAGE(PG8_SA(0, 1), cA + hstep, voffA);
        if (wr == 1) PG8_BAR;
        PG8_WAIT_V(2); PG8_BAR;
        PG8_STAGE(PG8_SB(1, 0), cB + kstep, voffB); PG8_STAGE(PG8_SA(1, 0), cA + kstep, voffA); PG8_STAGE(PG8_SB(1, 1), cB + hstep + kstep, voffB);
        PG8_WAIT_V(6); PG8_BAR;
    } else {
        PG8_STAGE(PG8_SB(0, 0), cB, voffB); PG8_STAGE(PG8_SA(0, 0), cA, voffA); PG8_STAGE(PG8_SB(0, 1), cB + hstep, voffB); PG8_STAGE(PG8_SA(0, 1), cA + hstep, voffA);
        if (wr == 1) PG8_BAR;
        PG8_WAIT_V(4); PG8_BAR;
        PG8_STAGE(PG8_SB(1, 0), cB + kstep, voffB); PG8_STAGE(PG8_SA(1, 0), cA + kstep, voffA); PG8_STAGE(PG8_SB(1, 1), cB + hstep + kstep, voffB);
        PG8_WAIT_V(6); PG8_BAR;
    }
    for (;;) {
        const bool has_next = S.next(ui + 1, nxt);
        const char* nA = has_next ? (const char*)g.A + (size_t)nxt.pm * tstep : cA; const char* nB = has_next ? (const char*)g.Bt + (size_t)nxt.pn * tstep : cB;
        for (int t = 0; t < nt; t += 2) {
            const bool last = (t == nt - 2);
            const char* a1 = cA + (size_t)(t + 1) * kstep;
            const char* a2 = last ? nA : cA + (size_t)(t + 2) * kstep; const char* b2 = last ? nB : cB + (size_t)(t + 2) * kstep;
            const char* a3 = a2 + kstep; const char* b3 = b2 + kstep;
            if (last && has_next) S.a_ready(nxt);
            if constexpr (SP2) {
            PG8_LDB(B0, 0, 0); PG8_LDB(B1, 0, 1); PG8_SCHED; PG8_LDA(At, 0, 0); PG8_STAGE(PG8_SA(1, 1), a1 + hstep, voffA);
            PG8_WAIT_V(8); PG8_WAIT_L(0); PG8_BAR; PG8_MMA(0, 0, At, B0); PG8_MMA(0, 1, At, B1); PG8_BAR; PG8_SCHED;
            PG8_LDA(At, 0, 1); PG8_STAGE(PG8_SB(0, 0), b2, voffB); PG8_STAGE(PG8_SB(0, 1), b2 + hstep, voffB); PG8_STAGE(PG8_SA(0, 0), a2, voffA);
            PG8_WAIT_V(8); PG8_WAIT_L(0); PG8_BAR; PG8_MMA(1, 0, At, B0); PG8_MMA(1, 1, At, B1); PG8_BAR; PG8_SCHED;
            PG8_LDB(B0, 1, 0); PG8_LDB(B1, 1, 1); PG8_SCHED; PG8_LDA(At, 1, 0); PG8_STAGE(PG8_SA(0, 1), a2 + hstep, voffA);
            PG8_WAIT_V(8); PG8_WAIT_L(0); PG8_BAR; PG8_MMA(0, 0, At, B0); PG8_MMA(0, 1, At, B1); PG8_BAR; PG8_SCHED;
            PG8_LDA(At, 1, 1); PG8_STAGE(PG8_SB(1, 0), b3, voffB); PG8_STAGE(PG8_SB(1, 1), b3 + hstep, voffB); PG8_STAGE(PG8_SA(1, 0), a3, voffA);
            PG8_WAIT_V(8); PG8_WAIT_L(0); PG8_BAR; PG8_MMA(1, 0, At, B0); PG8_MMA(1, 1, At, B1); PG8_BAR; PG8_SCHED;
            } else {
            PG8_LDB(B0, 0, 0); PG8_SCHED; PG8_LDA(At, 0, 0); PG8_STAGE(PG8_SA(1, 1), a1 + hstep, voffA);
            PG8_WAIT_L(8); PG8_BAR; PG8_WAIT_L(0); PG8_MMA(0, 0, At, B0); PG8_BAR; PG8_SCHED;
            PG8_LDB(B1, 0, 1); PG8_STAGE(PG8_SB(0, 0), b2, voffB);
            PG8_BAR; PG8_WAIT_L(0); PG8_MMA(0, 1, At, B1); PG8_BAR;
            PG8_LDA(At, 0, 1); PG8_STAGE(PG8_SA(0, 0), a2, voffA);
            PG8_BAR; PG8_WAIT_L(0); PG8_MMA(1, 0, At, B0); PG8_BAR; PG8_SCHED;
            PG8_STAGE(PG8_SB(0, 1), b2 + hstep, voffB);
            PG8_WAIT_V(6); PG8_BAR; PG8_MMA(1, 1, At, B1); PG8_BAR;
            PG8_LDB(B0, 1, 0); PG8_SCHED; PG8_LDA(At, 1, 0); PG8_STAGE(PG8_SA(0, 1), a2 + hstep, voffA);
            PG8_WAIT_L(8); PG8_BAR; PG8_WAIT_L(0); PG8_MMA(0, 0, At, B0); PG8_BAR; PG8_SCHED;
            PG8_LDB(B1, 1, 1); PG8_STAGE(PG8_SB(1, 0), b3, voffB);
            PG8_BAR; PG8_WAIT_L(0); PG8_MMA(0, 1, At, B1); PG8_BAR;
            PG8_LDA(At, 1, 1); PG8_STAGE(PG8_SA(1, 0), a3, voffA);
            PG8_BAR; PG8_WAIT_L(0); PG8_MMA(1, 0, At, B0); PG8_BAR; PG8_SCHED;
            PG8_STAGE(PG8_SB(1, 1), b3 + hstep, voffB);
            PG8_WAIT_V(6); PG8_BAR; PG8_MMA(1, 1, At, B1); PG8_BAR;
            }
        }
        if constexpr (ALIGN_EPI) { if (wr == 0) PG8_BAR; }
        if constexpr (!Epi::AFTER_DRAIN) { E(acc, cur, wr, wc, fr, fq); S.done(cur); }
        if (!has_next) break;
#pragma unroll
        for (int a = 0; a < 2; ++a)
#pragma unroll
            for (int b = 0; b < 2; ++b)
#pragma unroll
                for (int m = 0; m < 4; ++m)
#pragma unroll
                    for (int n = 0; n < 2; ++n) acc[a][b][m][n] = acc_t{};
        cur = nxt; cA = nA; cB = nB; ++ui;
        if constexpr (ALIGN_EPI) { if (wr == 1) PG8_BAR; }
    }
    PG8_WAIT_V(0);
    if constexpr (!ALIGN_EPI) { if (wr == 0) PG8_BAR; }
    PG8_BAR;
    if constexpr (Epi::AFTER_DRAIN) { E.fused(acc, cur, wr, wc, fr, fq, lds, wid, lane); S.done(cur); }
#undef PG8_SA
#undef PG8_SB
#undef PG8_STAGE
#undef PG8_LDA
#undef PG8_LDB
#undef PG8_MMA
#undef PG8_WAIT_V
#undef PG8_WAIT_L
#undef PG8_BAR
#undef PG8_SCHED
}
}

#include <hip/hip_bf16.h>
#include <cmath>
namespace attn_body {
using bf16=__hip_bfloat16;
using bf16x8=__attribute__((ext_vector_type(8)))short;
using s16x4=__attribute__((ext_vector_type(4)))short;
using f32x16=__attribute__((ext_vector_type(16)))float;
using u32x4=__attribute__((ext_vector_type(4)))unsigned;
constexpr int SEQ=4096,D=64,DM=512;
constexpr int NW=8,QBLK=32,QB=QBLK*NW,KVBLK=64,NQB=SEQ/QB;
constexpr int ATTN_PITCH=DM, ATTN_UNIT_ROWS=QB;
__device__ __forceinline__ int crow(int r,int hi){return (r&3)+8*(r>>2)+4*hi;}
#define SBAR() __builtin_amdgcn_sched_barrier(0)
__device__ __forceinline__ void cmask(f32x16&p0,f32x16&p1,int jb,int qrel,int hi){
  const float NEG=-INFINITY; int kb=64*jb+4*hi;
  #pragma unroll
  for(int r=0;r<16;++r){int kv=kb+(r&3)+8*(r>>2); if(kv>qrel)p0[r]=NEG; if(kv+32>qrel)p1[r]=NEG;}
}

constexpr int NSLOT=3, SLOTB=8192;
constexpr int LDS_K=0, LDS_V=NSLOT*SLOTB, LDS_V2=2*NSLOT*SLOTB, LDS_WS=3*NSLOT*SLOTB, LDS_OST=LDS_WS+NW*64*4, LDS_BYTES=LDS_OST+NW*4096;
constexpr float C2=0.125f*1.4426950408889634f;
__device__ __forceinline__ void glds16(const void*gsrc,unsigned lds_dst){unsigned keep;
  asm volatile("s_mov_b32 %0, m0\n\ts_mov_b32 m0, %2\n\ts_nop 0\n\tglobal_load_lds_dwordx4 %1, off\n\ts_mov_b32 m0, %0":"=&s"(keep):"v"(gsrc),"s"(lds_dst):"memory");}
__device__ __forceinline__ float max3f(float a,float b,float c){float r;asm("v_max3_f32 %0, %1, %2, %3":"=v"(r):"v"(a),"v"(b),"v"(c));return r;}
__device__ __forceinline__ float max2f(float a,float b){float r;asm("v_max_f32_e32 %0, %1, %2":"=v"(r):"v"(a),"v"(b));return r;}
__device__ __forceinline__ float fadd_s(float a,float b){float r;asm("v_add_f32_e32 %0, %1, %2":"=v"(r):"v"(a),"v"(b));return r;}
__device__ __forceinline__ float fsub_s(float a,float b){float r;asm("v_sub_f32_e32 %0, %1, %2":"=v"(r):"v"(a),"v"(b));return r;}
typedef float f32x2_t __attribute__((ext_vector_type(2))); typedef __bf16 bf16x2_t __attribute__((ext_vector_type(2)));
__device__ __forceinline__ unsigned cvtpk_s(float lo,float hi){f32x2_t v={lo,hi};bf16x2_t b=__builtin_convertvector(v,bf16x2_t);return __builtin_bit_cast(unsigned,b);}
#define WAIT_BAR(N) asm volatile("s_waitcnt vmcnt(" #N ") lgkmcnt(0)\n\ts_barrier":::"memory")

__device__ __forceinline__ void qkt(f32x16&p0,f32x16&p1,const char*Kslot,const bf16x8*qr,const f32x16&negm,int r32,int hi){
  const char*kb=Kslot+hi*1024+r32*16;
  #pragma unroll
  for(int d0=0;d0<4;++d0){
    const bf16x8 b0=*reinterpret_cast<const bf16x8*>(kb+d0*2048);
    const bf16x8 b1=*reinterpret_cast<const bf16x8*>(kb+d0*2048+512);
    if(d0==0){p0=__builtin_amdgcn_mfma_f32_32x32x16_bf16(b0,qr[0],negm,0,0,0);p1=__builtin_amdgcn_mfma_f32_32x32x16_bf16(b1,qr[0],negm,0,0,0);}
    else{p0=__builtin_amdgcn_mfma_f32_32x32x16_bf16(b0,qr[d0],p0,0,0,0);p1=__builtin_amdgcn_mfma_f32_32x32x16_bf16(b1,qr[d0],p1,0,0,0);}}
}
typedef __attribute__((address_space(3))) const char* lds_cptr;
typedef short v4i16_t __attribute__((ext_vector_type(4)));
__device__ __forceinline__ void kload8(bf16x8*kf,lds_cptr kp){
  kf[0]=*(const __attribute__((address_space(3))) bf16x8*)(kp);      kf[1]=*(const __attribute__((address_space(3))) bf16x8*)(kp+512);
  kf[2]=*(const __attribute__((address_space(3))) bf16x8*)(kp+2048); kf[3]=*(const __attribute__((address_space(3))) bf16x8*)(kp+2560);
  kf[4]=*(const __attribute__((address_space(3))) bf16x8*)(kp+4096); kf[5]=*(const __attribute__((address_space(3))) bf16x8*)(kp+4608);
  kf[6]=*(const __attribute__((address_space(3))) bf16x8*)(kp+6144); kf[7]=*(const __attribute__((address_space(3))) bf16x8*)(kp+6656);
}
__device__ __forceinline__ void kload2(bf16x8*kf,lds_cptr kp,int j){ kf[2*j]=*(const __attribute__((address_space(3))) bf16x8*)(kp+j*2048); kf[2*j+1]=*(const __attribute__((address_space(3))) bf16x8*)(kp+j*2048+512); }
__device__ __forceinline__ s16x4 vtr(lds_cptr p){ return __builtin_bit_cast(s16x4,__builtin_amdgcn_ds_read_tr16_b64_v4i16((__attribute__((address_space(3))) v4i16_t*)p)); }
__device__ __forceinline__ float rowmax(const f32x16&p0,const f32x16&p1){
  float a=max3f(p0[0],p0[1],p1[0]),b=max3f(p0[2],p0[3],p1[1]);a=max3f(a,p1[2],p1[3]);
  #pragma unroll
  for(int r=4;r<16;r+=4){a=max3f(a,p0[r],p0[r+1]);b=max3f(b,p0[r+2],p0[r+3]);a=max3f(a,p1[r],p1[r+1]);b=max3f(b,p1[r+2],p1[r+3]);}
  const float m=max2f(a,b);
  auto rr=__builtin_amdgcn_permlane32_swap(__float_as_uint(m),__float_as_uint(m),false,false);
  return max2f(__uint_as_float(rr[0]),__uint_as_float(rr[1]));
}
__device__ __forceinline__ void pv(f32x16*o,int vb,bf16x8 pa0,bf16x8 pa1,bf16x8 pa2,bf16x8 pa3){
  #pragma unroll
  for(int d0=0;d0<2;++d0){s16x4 lo[4],hi[4];
    #pragma unroll
    for(int ks=0;ks<4;++ks){
      asm volatile("ds_read_b64_tr_b16 %0,%1 offset:%c2":"=&v"(lo[ks]):"v"(vb),"i"(d0*4096+ks*1024):"memory");
      asm volatile("ds_read_b64_tr_b16 %0,%1 offset:%c2":"=&v"(hi[ks]):"v"(vb),"i"(d0*4096+ks*1024+512):"memory");}
    asm volatile("s_waitcnt lgkmcnt(0)":::"memory");SBAR();
    #define PK(k) (bf16x8){lo[k][0],lo[k][1],lo[k][2],lo[k][3],hi[k][0],hi[k][1],hi[k][2],hi[k][3]}
    o[d0]=__builtin_amdgcn_mfma_f32_32x32x16_bf16(pa0,PK(0),o[d0],0,0,0);
    o[d0]=__builtin_amdgcn_mfma_f32_32x32x16_bf16(pa1,PK(1),o[d0],0,0,0);
    o[d0]=__builtin_amdgcn_mfma_f32_32x32x16_bf16(pa2,PK(2),o[d0],0,0,0);
    o[d0]=__builtin_amdgcn_mfma_f32_32x32x16_bf16(pa3,PK(3),o[d0],0,0,0);
    #undef PK
  }
}

#ifndef ATTN_STORE16
#define ATTN_STORE16(p,v) (*(u32x4*)(p)=(v))
#endif
template<int THRL> __device__ __forceinline__ void attn_unit(int b,int cqk,int cvo,int qb,const bf16*Q,const bf16*__restrict__ K,const bf16*__restrict__ V,bf16*O,char*shm){
  const int tid=tid_fresh(),lane=tid&63,r32=lane&31,hi=lane>>5; const int wid=__builtin_amdgcn_readfirstlane(tid>>6);
  const long rowbase=(long)b*SEQ; const int q0=qb*QB;
  const bf16*Qw=Q+(rowbase+q0+wid*QBLK)*DM+cqk;
  const bf16*Kh=K+rowbase*DM+cqk,*Vh=V+rowbase*DM+cvo;
  const unsigned lds0=(unsigned)(uintptr_t)shm;
  float*wsf=(float*)(shm+LDS_WS)+wid*64;
  const bf16*ksrc=Kh+(long)lane*DM+wid*8;
  const bf16*vsrc=Vh+(long)(16*(wid&3)+(lane>>2))*DM+(wid>>2)*32+(lane&3)*8;
  const unsigned kdst=lds0+LDS_K+wid*1024, vdst=lds0+LDS_V+wid*1024, vdst2=lds0+LDS_V2+wid*1024;
  #define DMA_K(t,slot) glds16(ksrc+(long)(t)*KVBLK*DM,(unsigned)__builtin_amdgcn_readfirstlane(kdst+(slot)))
  #define DMA_V(t,slot) do{ glds16(vsrc+(long)(t)*KVBLK*DM,(unsigned)__builtin_amdgcn_readfirstlane(vdst+(slot))); glds16(vsrc+64+(long)(t)*KVBLK*DM,(unsigned)__builtin_amdgcn_readfirstlane(vdst2+(slot))); }while(0)
  const int vb0=(int)(lds0+LDS_V)+((lane>>4)&1)*32+(lane&3)*8+(4*hi+((lane&15)>>2))*64;
  const char*Kbase=shm+LDS_K; bf16x8 kf[8];
  const lds_cptr shm3=(lds_cptr)shm; const lds_cptr kp0=shm3+LDS_K+hi*1024+r32*16; const lds_cptr vp0=shm3+LDS_V+((lane>>4)&1)*32+(lane&3)*8+(4*hi+((lane&15)>>2))*64;
  const int NT=SEQ/KVBLK;
  DMA_K(0,0);DMA_V(0,0);DMA_K(1,SLOTB);
  bf16x8 qr[4];
  #pragma unroll
  for(int d0=0;d0<4;++d0)qr[d0]=*reinterpret_cast<const bf16x8*>(&Qw[(long)r32*DM+d0*16+hi*8]);
  float mhat=0.f,l_reg=0.f;f32x16 o[4];o[0]=f32x16{};o[1]=f32x16{};o[2]=f32x16{};o[3]=f32x16{};const f32x16 zero16=f32x16{};
  const int qrel=wid*QBLK+r32; (void)qrel;
  #define CMASK(P0,P1,t) do{}while(0)
  bool resc=false;
  #define START(P0,P1) do{ const float rm=rowmax(P0,P1); resc=false; \
    { const float dl=rm; mhat=fadd_s(mhat,dl); \
      _Pragma("unroll") for(int r=0;r<16;++r){P0[r]=fsub_s(P0[r],dl);P1[r]=fsub_s(P1[r],dl);} \
      } \
    _Pragma("unroll") for(int r=0;r<16;++r)P0[r]=__builtin_amdgcn_exp2f(P0[r]); }while(0)
  #define RESC() do{ if(resc){ asm volatile("s_waitcnt lgkmcnt(0)":::"memory"); \
      _Pragma("unroll") for(int d_=0;d_<4;++d_) _Pragma("unroll") for(int r=0;r<16;++r)o[d_][r]*=wsf[crow(r,hi)]; } }while(0)
  f32x16 pA0,pA1,pB0,pB1;
  int sl_prev=0,sl_cur=0,sl_next=SLOTB;
  #define ROT() do{sl_prev=sl_cur;sl_cur=sl_next;sl_next=(sl_next==(NSLOT-1)*SLOTB)?0:sl_next+SLOTB;}while(0)
  DMA_K(2,2*SLOTB);
  WAIT_BAR(4);
  qkt(pA0,pA1,Kbase,qr,zero16,r32,hi);asm volatile("s_nop 15\n\ts_nop 7":"+v"(pA0),"+v"(pA1));CMASK(pA0,pA1,0);
  START(pA0,pA1);
  _Pragma("unroll") for(int r=0;r<16;++r)pA1[r]=__builtin_amdgcn_exp2f(pA1[r]);
  WAIT_BAR(0);
  DMA_K(3,0);DMA_V(1,SLOTB);
  ROT();
  kload8(kf,kp0+sl_cur);
  WAIT_BAR(3);
  s16x4 vlo[8],vhi[8]; u32x4 pw0,pw1,pw2,pw3;
  #define PKW(P,B) cvtpk_s(P[B],P[B+1])
  #define PAF(k) __builtin_bit_cast(bf16x8,pw##k)
  #define VFR(i) (bf16x8){vlo[i][0],vlo[i][1],vlo[i][2],vlo[i][3],vhi[i][0],vhi[i][1],vhi[i][2],vhi[i][3]}
  #define PIN(x) asm volatile("":"+v"(x))
  #define MX3(a,b,c) __builtin_fmaxf(__builtin_fmaxf((a),(b)),(c))
  #define GAPA(MF,A0,A1,A2,A3,W0,W1,PW) do{ MF; sacc+=A0; sacc+=A1; sacc+=A2; sacc+=A3; PIN(sacc); W0; W1; PIN(PW); SBAR(); }while(0)
  #define EX(v) __builtin_amdgcn_exp2f(v)
  #define GAPB(MF,X,B) do{ MF; X[B]=EX(X[B]); X[B+1]=EX(X[B+1]); X[B+2]=EX(X[B+2]); X[B+3]=EX(X[B+3]); PIN(X); SBAR(); }while(0)
  #define VRD(i) do{ vlo[i]=vtr(vp_+(((i)>>2)*4096+((i)&3)*1024)); vhi[i]=vtr(vp_+(((i)>>2)*4096+((i)&3)*1024+512)); }while(0)
  #define KRD(G,j) do{ if(G){ kload2(kf,kp0+sl_next,j); SBAR(); } }while(0)
  #define STEP(C0,C1,P0,P1,t,GK,GV,GL) do{ SBAR(); \
    const lds_cptr vp_=vp0+sl_prev; \
    VRD(0); SBAR(); float sacc=(P0[0]+P0[1]); \
    GAPA(C0=__builtin_amdgcn_mfma_f32_32x32x16_bf16(kf[0],qr[0],zero16,0,0,0), P0[2],P0[3],P0[4],P0[5],     pw0[0]=PKW(P0,0), pw0[1]=PKW(P0,2), pw0); \
    VRD(4); SBAR(); GAPA(C1=__builtin_amdgcn_mfma_f32_32x32x16_bf16(kf[1],qr[0],zero16,0,0,0), P0[6],P0[7],P0[8],P0[9],     pw0[2]=PKW(P0,4), pw0[3]=PKW(P0,6), pw0); \
    VRD(1); SBAR(); GAPA(C0=__builtin_amdgcn_mfma_f32_32x32x16_bf16(kf[2],qr[1],C0,0,0,0),   P0[10],P0[11],P0[12],P0[13], pw1[0]=PKW(P0,8), pw1[1]=PKW(P0,10), pw1); \
    VRD(5); SBAR(); GAPA(C1=__builtin_amdgcn_mfma_f32_32x32x16_bf16(kf[3],qr[1],C1,0,0,0),   P0[14],P0[15],P1[0],P1[1],   pw1[2]=PKW(P0,12),pw1[3]=PKW(P0,14), pw1); \
    VRD(2); SBAR(); GAPA(C0=__builtin_amdgcn_mfma_f32_32x32x16_bf16(kf[4],qr[2],C0,0,0,0),   P1[2],P1[3],P1[4],P1[5],     pw2[0]=PKW(P1,0), pw2[1]=PKW(P1,2), pw2); \
    VRD(6); SBAR(); GAPA(C1=__builtin_amdgcn_mfma_f32_32x32x16_bf16(kf[5],qr[2],C1,0,0,0),   P1[6],P1[7],P1[8],P1[9],     pw2[2]=PKW(P1,4), pw2[3]=PKW(P1,6), pw2); \
    VRD(3); SBAR(); GAPA(C0=__builtin_amdgcn_mfma_f32_32x32x16_bf16(kf[6],qr[3],C0,0,0,0),   P1[10],P1[11],P1[12],P1[13], pw3[0]=PKW(P1,8), pw3[1]=PKW(P1,10), pw3); \
    VRD(7); SBAR(); GAPA(C1=__builtin_amdgcn_mfma_f32_32x32x16_bf16(kf[7],qr[3],C1,0,0,0),   P1[14],P1[15],0.f,0.f,       pw3[2]=PKW(P1,12),pw3[3]=PKW(P1,14), pw3); \
    l_reg+=sacc; \
    if(GK){DMA_K((t)+3,sl_cur);} if(GV){DMA_V((t)+1,sl_next);} \
    CMASK(C0,C1,t); \
    _Pragma("unroll") for(int r=0;r<16;++r){C0[r]-=mhat;C1[r]-=mhat;} \
    { float a=MX3(C0[0],C0[1],C1[0]),b=MX3(C0[2],C0[3],C1[1]); a=MX3(a,C1[2],C1[3]); \
      _Pragma("unroll") for(int r=4;r<16;r+=4){a=MX3(a,C0[r],C0[r+1]);b=MX3(b,C0[r+2],C0[r+3]);a=MX3(a,C1[r],C1[r+1]);b=MX3(b,C1[r+2],C1[r+3]);} \
      float rm=__builtin_fmaxf(a,b); { auto rr=__builtin_amdgcn_permlane32_swap(__float_as_uint(rm),__float_as_uint(rm),false,false); rm=__builtin_fmaxf(__uint_as_float(rr[0]),__uint_as_float(rr[1])); } \
      resc=false; \
      if(__builtin_expect(__any(rm>(float)THRL),0)){ const float dl=__builtin_fmaxf(rm,0.f); mhat+=dl; \
        _Pragma("unroll") for(int r=0;r<16;++r){C0[r]-=dl;C1[r]-=dl;} \
        const float f=__builtin_amdgcn_exp2f(-dl); l_reg*=f; if(hi==0)wsf[r32]=f; resc=true; } } \
    SBAR(); \
    GAPB(o[0]=__builtin_amdgcn_mfma_f32_32x32x16_bf16(PAF(0),VFR(0),o[0],0,0,0), C0,0); \
    GAPB(o[1]=__builtin_amdgcn_mfma_f32_32x32x16_bf16(PAF(0),VFR(4),o[1],0,0,0), C0,4); \
    KRD(GL,0); GAPB(o[0]=__builtin_amdgcn_mfma_f32_32x32x16_bf16(PAF(1),VFR(1),o[0],0,0,0), C0,8); \
    KRD(GL,1); GAPB(o[1]=__builtin_amdgcn_mfma_f32_32x32x16_bf16(PAF(1),VFR(5),o[1],0,0,0), C0,12); \
    KRD(GL,2); GAPB(o[0]=__builtin_amdgcn_mfma_f32_32x32x16_bf16(PAF(2),VFR(2),o[0],0,0,0), C1,0); \
    KRD(GL,3); GAPB(o[1]=__builtin_amdgcn_mfma_f32_32x32x16_bf16(PAF(2),VFR(6),o[1],0,0,0), C1,4); \
    GAPB(o[0]=__builtin_amdgcn_mfma_f32_32x32x16_bf16(PAF(3),VFR(3),o[0],0,0,0), C1,8); \
    GAPB(o[1]=__builtin_amdgcn_mfma_f32_32x32x16_bf16(PAF(3),VFR(7),o[1],0,0,0), C1,12); \
      \
    { const lds_cptr vq_=vp0+(LDS_V2-LDS_V)+sl_prev; \
      _Pragma("unroll") for(int i_=0;i_<8;++i_){ vlo[i_]=vtr(vq_+((i_>>2)*4096+(i_&3)*1024)); vhi[i_]=vtr(vq_+((i_>>2)*4096+(i_&3)*1024+512)); } \
      o[2]=__builtin_amdgcn_mfma_f32_32x32x16_bf16(PAF(0),VFR(0),o[2],0,0,0); o[3]=__builtin_amdgcn_mfma_f32_32x32x16_bf16(PAF(0),VFR(4),o[3],0,0,0); \
      o[2]=__builtin_amdgcn_mfma_f32_32x32x16_bf16(PAF(1),VFR(1),o[2],0,0,0); o[3]=__builtin_amdgcn_mfma_f32_32x32x16_bf16(PAF(1),VFR(5),o[3],0,0,0); \
      o[2]=__builtin_amdgcn_mfma_f32_32x32x16_bf16(PAF(2),VFR(2),o[2],0,0,0); o[3]=__builtin_amdgcn_mfma_f32_32x32x16_bf16(PAF(2),VFR(6),o[3],0,0,0); \
      o[2]=__builtin_amdgcn_mfma_f32_32x32x16_bf16(PAF(3),VFR(3),o[2],0,0,0); o[3]=__builtin_amdgcn_mfma_f32_32x32x16_bf16(PAF(3),VFR(7),o[3],0,0,0); SBAR(); } \
    }while(0)
  int t=1;
  #undef CMASK
  #define CMASK(P0,P1,t) do{}while(0)
  for(;t+5<NT;t+=2){
    STEP(pB0,pB1,pA0,pA1,t,true,true,true);     WAIT_BAR(3); RESC(); ROT();
    STEP(pA0,pA1,pB0,pB1,t+1,true,true,true);   WAIT_BAR(3); RESC(); ROT();
  }
  #undef CMASK
  #define CMASK(P0,P1,t) do{}while(0)
  #define ENDW(tt) do{ if((tt)+3<NT){WAIT_BAR(3);} else if((tt)+2<NT){WAIT_BAR(2);} else {WAIT_BAR(0);} }while(0)
  for(;t+1<NT;t+=2){
    STEP(pB0,pB1,pA0,pA1,t,(t+3<NT),(t+1<NT),(t+1<NT));       ENDW(t);   RESC(); ROT();
    STEP(pA0,pA1,pB0,pB1,t+1,(t+4<NT),(t+2<NT),(t+2<NT));     ENDW(t+1); RESC(); ROT();
  }
  STEP(pB0,pB1,pA0,pA1,NT-1,false,false,false); RESC();
  { float sacc=pB0[0]+pB0[1]; _Pragma("unroll") for(int r=2;r<16;++r)sacc+=pB0[r]; _Pragma("unroll") for(int r=0;r<16;++r)sacc+=pB1[r]; l_reg+=sacc;
    pw0=(u32x4){PKW(pB0,0),PKW(pB0,2),PKW(pB0,4),PKW(pB0,6)};pw1=(u32x4){PKW(pB0,8),PKW(pB0,10),PKW(pB0,12),PKW(pB0,14)};pw2=(u32x4){PKW(pB1,0),PKW(pB1,2),PKW(pB1,4),PKW(pB1,6)};pw3=(u32x4){PKW(pB1,8),PKW(pB1,10),PKW(pB1,12),PKW(pB1,14)};
    SBAR(); pv(o,vb0+sl_cur,PAF(0),PAF(1),PAF(2),PAF(3)); pv(o+2,vb0+(LDS_V2-LDS_V)+sl_cur,PAF(0),PAF(1),PAF(2),PAF(3)); }
  #undef PKW
  #undef PAF
  #undef VFR
  #undef PIN
  #undef MX3
  #undef GAPA
  #undef GAPB
  #undef EX
  #undef VRD
  #undef KRD
  #undef STEP
  #undef ENDW
  {auto rr=__builtin_amdgcn_permlane32_swap(__float_as_uint(l_reg),__float_as_uint(l_reg),false,false);l_reg=__uint_as_float(rr[0])+__uint_as_float(rr[1]);}
  if(hi==0)wsf[32+r32]=l_reg;asm volatile("s_waitcnt lgkmcnt(0)":::"memory");
  float rli[16];
  #pragma unroll
  for(int r=0;r<16;++r)rli[r]=__builtin_amdgcn_rcpf(wsf[32+crow(r,hi)]);
  bf16*Ow=O+(rowbase+q0+wid*QBLK)*DM+cvo;
  { bf16*stg=(bf16*)(shm+LDS_OST)+wid*2048;
    #pragma unroll
    for(int ph=0;ph<2;++ph){
    #pragma unroll
    for(int r=0;r<16;++r){const int orow=crow(r,hi);
      #pragma unroll
      for(int d0=0;d0<2;++d0)stg[orow*64+d0*32+r32]=__float2bfloat16(o[2*ph+d0][r]*rli[r]);}
    asm volatile("s_waitcnt lgkmcnt(0)":::"memory");
    #pragma unroll
    for(int i=0;i<4;++i){const int row=i*8+(lane>>3),ch=lane&7; const u32x4 v=*(const u32x4*)(stg+row*64+ch*8); ATTN_STORE16(Ow+(long)row*DM+ph*64+ch*8,v);}
    asm volatile("s_waitcnt lgkmcnt(0)":::"memory"); } }
  asm volatile("s_waitcnt lgkmcnt(0)\n\ts_barrier":::"memory");
  #undef DMA_K
  #undef DMA_V
  #undef CMASK
  #undef START
  #undef RESC
  #undef ROT
}
constexpr int ATTN_LDS_BYTES=LDS_BYTES;
#undef SBAR
#undef WAIT_BAR
}

namespace dil {
constexpr int D = 128;
constexpr float THR = 8.f;
constexpr bool WSKIP = true;
constexpr float SCALE = 0.08838834764831845f;
constexpr int NW = 8, QBLK = 32, KVBLK = 64, QB = NW * QBLK;
constexpr int SHM_V = KVBLK * D * 2, SHM_K = KVBLK * D * 2;
constexpr int LDS_OST = 2 * SHM_V + 2 * SHM_K + NW * 64 * 4;
constexpr int LDS_BYTES = LDS_OST + NW * 4096;
using bf16 = __hip_bfloat16;
typedef short bf16x8 __attribute__((ext_vector_type(8)));
typedef short s16x4 __attribute__((ext_vector_type(4)));
typedef float f32x16 __attribute__((ext_vector_type(16)));
typedef float f32x4 __attribute__((ext_vector_type(4)));
typedef unsigned u32x4 __attribute__((ext_vector_type(4)));
template <class A, class Bt> struct same_t { static constexpr bool v = false; };
template <class A> struct same_t<A, A> { static constexpr bool v = true; };

#define KSWZ(row, colB) ((row) * 256 + ((colB) ^ (((row) & 7) << 4)))
#define SBAR() __builtin_amdgcn_sched_barrier(0)
__device__ __forceinline__ int v_st(int k, int c) { const int kk = (k & ~0xC) | ((k & 4) << 1) | ((k & 8) >> 1); return ((kk >> 3) * 4 + (c >> 5)) * 512 + ((kk & 7) * 32 + (c & 31)) * 2; }
__device__ __forceinline__ int v_rd_base(int lane) { return ((lane & 3) << 3) | (((lane >> 2) & 3) << 6) | (((lane >> 4) & 1) << 5) | (((lane >> 5) & 1) << 8); }
constexpr int v_rd_off(int d0, int ks, int half) { return d0 * 512 + ks * 4096 + half * 2048; }
__device__ __forceinline__ int crow(int r, int hi) { return (r & 3) + 8 * (r >> 2) + 4 * hi; }
__device__ __forceinline__ unsigned cvtpk(float lo, float hi) {
    unsigned r; asm volatile("v_cvt_pk_bf16_f32 %0, %1, %2" : "=v"(r) : "v"(lo), "v"(hi)); return r;
}
__device__ __forceinline__ bf16x8 pack8(f32x4 a, f32x4 b) {
    u32x4 w = {cvtpk(a[0], a[1]), cvtpk(a[2], a[3]), cvtpk(b[0], b[1]), cvtpk(b[2], b[3])};
    return *reinterpret_cast<bf16x8*>(&w);
}
template <class T> __device__ __forceinline__ bf16x8 load8(const T* p) {
    if constexpr (same_t<T, float>::v) { return pack8(*(const f32x4*)p, *(const f32x4*)(p + 4)); }
    else { return *reinterpret_cast<const bf16x8*>(p); }
}
__device__ __forceinline__ void mask_tile(f32x16& p0, f32x16& p1, int dq, unsigned W) {
    const float NEG = -__builtin_inff();
#pragma unroll
    for (int r = 0; r < 16; ++r) {
        const int c = (r & 3) + 8 * (r >> 2);
        if ((unsigned)(dq - c) >= W) p0[r] = NEG;
        if ((unsigned)(dq - c - 32) >= W) p1[r] = NEG;
    }
}
__device__ __forceinline__ void partialSM(f32x16& p0, f32x16& p1, float& m_reg, float& mn, float& alpha) {
    float pmax = p0[0]; for (int r = 1; r < 16; ++r) pmax = fmaxf(pmax, p0[r]); for (int r = 0; r < 16; ++r) pmax = fmaxf(pmax, p1[r]);
    { auto rr = __builtin_amdgcn_permlane32_swap(__float_as_uint(pmax), __float_as_uint(pmax), false, false);
      pmax = fmaxf(__uint_as_float(rr[0]), __uint_as_float(rr[1])); }
    constexpr float C2 = 1.4426950408889634f * SCALE;
    if (__builtin_expect(__all((pmax - m_reg) * SCALE <= THR), 1)) { mn = m_reg; alpha = 1.f; }
    else { mn = fmaxf(m_reg, pmax); alpha = __builtin_amdgcn_exp2f((m_reg - mn) * C2); m_reg = mn; }
    const float mnL = -mn * C2;
    for (int r = 0; r < 16; ++r) p0[r] = fmaf(p0[r], C2, mnL); for (int r = 0; r < 16; ++r) p1[r] = fmaf(p1[r], C2, mnL);
    for (int r = 0; r < 16; ++r) p0[r] = __builtin_amdgcn_exp2f(p0[r]);
}
__device__ __forceinline__ void finishSM(f32x16& p0, f32x16& p1, float alpha, float& l_reg, bf16x8& pa0, bf16x8& pa1, bf16x8& pa2, bf16x8& pa3) {
    for (int r = 0; r < 16; ++r) p1[r] = __builtin_amdgcn_exp2f(p1[r]);
    float ps = 0; for (int r = 0; r < 16; ++r) ps += p0[r]; for (int r = 0; r < 16; ++r) ps += p1[r];
    { auto rr = __builtin_amdgcn_permlane32_swap(__float_as_uint(ps), __float_as_uint(ps), false, false);
      ps = __uint_as_float(rr[0]) + __uint_as_float(rr[1]); }
    l_reg = l_reg * alpha + ps;
#define PK4(P, B_, OUT) do { unsigned a0 = cvtpk(P[B_+0], P[B_+1]), a1 = cvtpk(P[B_+2], P[B_+3]);                          \
        unsigned b0 = cvtpk(P[B_+4], P[B_+5]), b1 = cvtpk(P[B_+6], P[B_+7]);                                             \
        auto r0 = __builtin_amdgcn_permlane32_swap(a0, b0, false, false); auto r1 = __builtin_amdgcn_permlane32_swap(a1, b1, false, false); \
        u32x4 w = {r0[0], r1[0], r0[1], r1[1]}; OUT = *reinterpret_cast<bf16x8*>(&w); } while (0)
    PK4(p0, 0, pa0); PK4(p0, 8, pa1); PK4(p1, 0, pa2); PK4(p1, 8, pa3);
#undef PK4
}
template <int KB, bool SK>
__device__ __forceinline__ void qkt(f32x16& p0, f32x16& p1, const char* K_lds, int r32, int hi, const bf16x8* qr, bool act) {
    if (SK && !act) { const float NEG = -__builtin_inff();
#pragma unroll
        for (int r = 0; r < 16; ++r) { p0[r] = NEG; p1[r] = NEG; } return; }
    p0 = f32x16{}; p1 = f32x16{};
    const char* kb[4];
#pragma unroll
    for (int dd = 0; dd < 4; ++dd) kb[dd] = K_lds + KB * SHM_K + KSWZ(r32, (dd * 16 + hi * 8) * 2);
#pragma unroll
    for (int d0 = 0; d0 < 8; ++d0) { const char* a = kb[d0 & 3] + (d0 >> 2) * 128;
        bf16x8 b0 = *reinterpret_cast<const bf16x8*>(a);
        bf16x8 b1 = *reinterpret_cast<const bf16x8*>(a + 32 * 256);
        p0 = __builtin_amdgcn_mfma_f32_32x32x16_bf16(b0, qr[d0], p0, 0, 0, 0);
        p1 = __builtin_amdgcn_mfma_f32_32x32x16_bf16(b1, qr[d0], p1, 0, 0, 0); }
}
template <int VB, bool SK>
__device__ __forceinline__ void pv_tile(f32x16* o, int vb0, bf16x8 pa0, bf16x8 pa1, bf16x8 pa2, bf16x8 pa3, bool act) {
    if (SK && !act) return;
#define TRRD(dst, off) asm volatile("ds_read_b64_tr_b16 %0, %1 offset:%2" : "=&v"(dst) : "v"(vb0), "i"(off) : "memory")
#define PV_D0(d0) do { s16x4 l0, l1, l2, l3, h0, h1, h2, h3; constexpr int b_ = VB * SHM_V + v_rd_off(d0, 0, 0);     \
        TRRD(l0, b_); TRRD(h0, b_ + 2048); TRRD(l1, b_ + 4096); TRRD(h1, b_ + 6144); TRRD(l2, b_ + 8192); TRRD(h2, b_ + 10240); TRRD(l3, b_ + 12288); TRRD(h3, b_ + 14336); \
        asm volatile("s_waitcnt lgkmcnt(0)" ::: "memory"); SBAR();                 \
        o[d0] = __builtin_amdgcn_mfma_f32_32x32x16_bf16(pa0, (bf16x8){l0[0], l0[1], l0[2], l0[3], h0[0], h0[1], h0[2], h0[3]}, o[d0], 0, 0, 0);   \
        o[d0] = __builtin_amdgcn_mfma_f32_32x32x16_bf16(pa1, (bf16x8){l1[0], l1[1], l1[2], l1[3], h1[0], h1[1], h1[2], h1[3]}, o[d0], 0, 0, 0);   \
        o[d0] = __builtin_amdgcn_mfma_f32_32x32x16_bf16(pa2, (bf16x8){l2[0], l2[1], l2[2], l2[3], h2[0], h2[1], h2[2], h2[3]}, o[d0], 0, 0, 0);   \
        o[d0] = __builtin_amdgcn_mfma_f32_32x32x16_bf16(pa3, (bf16x8){l3[0], l3[1], l3[2], l3[3], h3[0], h3[1], h3[2], h3[3]}, o[d0], 0, 0, 0); } while (0)
    PV_D0(0); PV_D0(1); PV_D0(2); PV_D0(3);
#undef PV_D0
#undef TRRD
}

template <class TIn, class TOut> struct BlockRef { const TIn* Q; const TIn* K; const TIn* V; TOut* O; float* LSE; int P0; int rs; int lrs; int skv; };
template <class TIn> struct Seam {
    bf16x8 qr[8];
    bf16x8 st_v0, st_v1, st_k0, st_k1; f32x4 sf0, sf1, sf2, sf3;
    f32x4 tq[16];
};
__device__ __forceinline__ int swa_jlo(int P0, int W) { const int lowk = P0 - 64; (void)W; return lowk > 0 ? lowk / KVBLK : 0; }
#define ROW(p, k0, rr) ((p) + (size_t)((k0) + (rr)) * RS_ + sc)
#define VMW() asm volatile("s_waitcnt vmcnt(0)" ::: "memory")
#define VMWN(n) asm volatile("s_waitcnt vmcnt(%0)" :: "i"(n) : "memory")
#define SLOAD_H(Kp, Vp, k0) do { S.st_v0 = load8<TIn>(ROW(Vp, k0, sr)); S.st_v1 = load8<TIn>(ROW(Vp, k0, 32 + sr));              \
                         S.st_k0 = load8<TIn>(ROW(Kp, k0, sr)); S.st_k1 = load8<TIn>(ROW(Kp, k0, 32 + sr)); } while (0)
#define SWRITE_HK(bf) do { *(bf16x8*)(K_lds + (bf) * SHM_K + kws) = S.st_k0; *(bf16x8*)(K_lds + (bf) * SHM_K + kws + 32 * 256) = S.st_k1; } while (0)
#define SWRITE_HV(bf) do { *(bf16x8*)(V_lds + (bf) * SHM_V + vst0) = S.st_v0; *(bf16x8*)(V_lds + (bf) * SHM_V + vst1) = S.st_v1; } while (0)
#define SWRITE_H(bf) do { SWRITE_HV(bf); SWRITE_HK(bf); } while (0)
#define SLOAD_F(p, k0) do { S.sf0 = *(const f32x4*)ROW(p, k0, sr); S.sf1 = *(const f32x4*)(ROW(p, k0, sr) + 4);                \
                            S.sf2 = *(const f32x4*)ROW(p, k0, 32 + sr); S.sf3 = *(const f32x4*)(ROW(p, k0, 32 + sr) + 4); } while (0)
#define SWRITE_KF(bf) do { *(bf16x8*)(K_lds + (bf) * SHM_K + kws) = pack8(S.sf0, S.sf1); *(bf16x8*)(K_lds + (bf) * SHM_K + kws + 32 * 256) = pack8(S.sf2, S.sf3); } while (0)
#define SWRITE_VF(bf) do { *(bf16x8*)(V_lds + (bf) * SHM_V + vst0) = pack8(S.sf0, S.sf1); *(bf16x8*)(V_lds + (bf) * SHM_V + vst1) = pack8(S.sf2, S.sf3); } while (0)
template <class TIn, class TOut>
__device__ __forceinline__ void causal_swa_prime(const BlockRef<TIn, TOut>& cur, int W, char* lds, Seam<TIn>& S) {
    constexpr bool F32 = same_t<TIn, float>::v;
    const int tid = tid_fresh(), wid = __builtin_amdgcn_readfirstlane(tid >> 6), lane = tid & 63, r32 = lane & 31, hi = lane >> 5;
    const int sr = tid >> 4, sc = (tid & 15) * 8, kws = KSWZ(sr, sc * 2); char* K_lds = lds + 2 * SHM_V;
    const int kb0 = swa_jlo(cur.P0, W) * KVBLK; const size_t RS_ = (size_t)cur.rs;
    for (int d0 = 0; d0 < 8; ++d0) S.qr[d0] = load8<TIn>(cur.Q + (size_t)(wid * QBLK + r32) * RS_ + d0 * 16 + hi * 8);
    if constexpr (F32) { SLOAD_F((const float*)cur.K, kb0); VMW(); SWRITE_KF(0); SBAR(); SLOAD_F((const float*)cur.V, kb0); }
    else { SLOAD_H(cur.K, cur.V, kb0); VMW(); SWRITE_HK(0); }
    __syncthreads();
}
template <class TIn, class TOut>
__device__ __forceinline__ void causal_swa_block(const BlockRef<TIn, TOut>& cur, const BlockRef<TIn, TOut>& nxt, int W, char* lds, Seam<TIn>& S) {
    constexpr bool F32 = same_t<TIn, float>::v;
    const int tid = tid_fresh(), wid = __builtin_amdgcn_readfirstlane(tid >> 6), lane = tid & 63, r32 = lane & 31, hi = lane >> 5;
    const int j_lo = swa_jlo(cur.P0, W);
    int j_hi = (cur.P0 + QB - 1 + 64) / KVBLK + 1; if (j_hi > cur.skv / KVBLK) j_hi = cur.skv / KVBLK;
    const int NT = j_hi - j_lo;
    const int kbn = swa_jlo(nxt.P0, W) * KVBLK;
    const int qlo = cur.P0 + wid * QBLK, qm = qlo + r32 - 4 * hi;
    char* V_lds = lds; char* K_lds = lds + 2 * SHM_V;
    float* ws = (float*)(lds + 2 * SHM_V + 2 * SHM_K) + wid * 64; float* li_l = ws, * al_l = ws + 32;
    float m_reg = -1e30f, l_reg = 0; f32x16 o[4] = {};
    const int sr = tid >> 4, sc = (tid & 15) * 8, vst0 = v_st(sr, sc), vst1 = v_st(32 + sr, sc), kws = KSWZ(sr, sc * 2);
    const int vb0 = (int)(uintptr_t)V_lds + v_rd_base(lane);
    const TIn* Kh = cur.K; const TIn* Vh = cur.V; size_t RS_ = (size_t)cur.rs;
#define RESC(a) do { if (__any((a) < 1.f)) { if (hi == 0) al_l[r32] = (a); asm volatile("s_waitcnt lgkmcnt(0)" ::: "memory");              \
                     for (int d_ = 0; d_ < 4; ++d_) for (int r = 0; r < 16; ++r) o[d_][r] *= al_l[crow(r, hi)]; } } while (0)
#define KBASE(t) ((j_lo + (t)) * KVBLK)
#define ACT(t) (KBASE(t) <= qlo + QBLK - 1 + 64 && KBASE(t) + KVBLK - 1 >= qlo - 64)
#define MASKT(P0_, P1_, t) do { const int kb_ = KBASE(t); if (!SK || ACT(t)) mask_tile(P0_, P1_, qm - kb_ + 64, 129u); } while (0)
    constexpr int NQL = F32 ? 16 : 8;
    constexpr bool SK = WSKIP && !F32;
#define SEAM_K0() do { VMWN(NQL); if constexpr (F32) { SWRITE_KF(0); SBAR(); SLOAD_F((const float*)nxt.V, kbn); } else { SWRITE_HK(0); } SBAR(); } while (0)
    f32x16 pA0, pA1, pB0, pB1; float mnA, mnB, alA, alB; bf16x8 pa0, pa1, pa2, pa3;
    if constexpr (F32) { VMW(); SWRITE_VF(0); SBAR(); } else { SWRITE_HV(0); SBAR(); }
    if (NT > 1) { if constexpr (F32) SLOAD_F((const float*)Kh, KBASE(1)); else SLOAD_H(Kh, Vh, KBASE(1)); }
    SBAR(); qkt<0, SK>(pA0, pA1, K_lds, r32, hi, S.qr, ACT(0));
    if constexpr (F32) { if (NT > 1) { VMW(); SWRITE_KF(1); SBAR(); SLOAD_F((const float*)Vh, KBASE(1)); } }
    MASKT(pA0, pA1, 0); partialSM(pA0, pA1, m_reg, mnA, alA);
    if (NT > 1) { VMW(); if constexpr (F32) { SWRITE_VF(1); SBAR(); if (NT > 2) SLOAD_F((const float*)Kh, KBASE(2)); } else SWRITE_H(1); }
    __syncthreads();
#define HALF_STEP(PX0, PX1, mnX, alX, PY0, PY1, alY, t, KB, VB, SB) do {                                                      \
        SBAR(); qkt<KB, SK>(PX0, PX1, K_lds, r32, hi, S.qr, ACT(t));                                             \
        finishSM(PY0, PY1, alY, l_reg, pa0, pa1, pa2, pa3); SBAR();                                                           \
        if ((t) + 1 < NT) { if constexpr (F32) { VMW(); SWRITE_KF(SB); SBAR(); SLOAD_F((const float*)Vh, KBASE((t) + 1)); }  \
                            else { SLOAD_H(Kh, Vh, KBASE((t) + 1)); } SBAR(); }                                               \
        pv_tile<VB, SK>(o, vb0, pa0, pa1, pa2, pa3, ACT((t) - 1)); MASKT(PX0, PX1, (t)); partialSM(PX0, PX1, m_reg, mnX, alX);                                        \
        __syncthreads();                                                                                                      \
        if ((t) + 1 < NT) { VMW(); if constexpr (F32) { SWRITE_VF(SB); SBAR(); if ((t) + 2 < NT) SLOAD_F((const float*)Kh, KBASE((t) + 2)); } \
                            else { SWRITE_H(SB); } }                                                                          \
        RESC(alX); __syncthreads(); } while (0)
    for (int t = 1; t + 1 < NT; t += 2) {
        HALF_STEP(pB0, pB1, mnB, alB, pA0, pA1, alA, t, 1, 0, 0);
        HALF_STEP(pA0, pA1, mnA, alA, pB0, pB1, alB, t + 1, 0, 1, 1);
    }
    const bool even = (NT & 1) == 0;
    if (even) { SBAR(); qkt<1, SK>(pB0, pB1, K_lds, r32, hi, S.qr, ACT(NT - 1)); SBAR(); }
#define QROW(e) (nxt.Q + (size_t)(wid * QBLK + r32) * (size_t)nxt.rs + ((e) >> 1) * 16 + hi * 8 + ((e) & 1) * 4)
    RS_ = (size_t)nxt.rs;
    if constexpr (F32) { SLOAD_F((const float*)nxt.K, kbn); SBAR();
#pragma unroll
        for (int e = 0; e < 8; ++e) S.tq[e] = *(const f32x4*)QROW(e); }
    else { SLOAD_H(nxt.K, nxt.V, kbn); SBAR();
#pragma unroll
        for (int d0 = 0; d0 < 8; ++d0) S.qr[d0] = load8<TIn>(nxt.Q + (size_t)(wid * QBLK + r32) * (size_t)nxt.rs + d0 * 16 + hi * 8); }
    SBAR();
    finishSM(pA0, pA1, alA, l_reg, pa0, pa1, pa2, pa3); SBAR();
    if constexpr (F32) {
#pragma unroll
        for (int e = 8; e < 16; ++e) S.tq[e] = *(const f32x4*)QROW(e); SBAR(); }
#undef QROW
    pv_tile<0, SK>(o, vb0, pa0, pa1, pa2, pa3, ACT(even ? NT - 2 : NT - 1));
    if (even) { MASKT(pB0, pB1, NT - 1); partialSM(pB0, pB1, m_reg, mnB, alB); __syncthreads(); RESC(alB);
        finishSM(pB0, pB1, alB, l_reg, pa0, pa1, pa2, pa3); SBAR(); pv_tile<1, SK>(o, vb0, pa0, pa1, pa2, pa3, ACT(NT - 1)); }
    SBAR(); SEAM_K0();
    if (hi == 0) { li_l[r32] = l_reg; cur.LSE[(size_t)(wid * QBLK + r32) * (size_t)cur.lrs] = m_reg * SCALE + __builtin_amdgcn_logf(l_reg) * 0.6931471805599453f; }
    asm volatile("s_waitcnt lgkmcnt(0)" ::: "memory");
    float rli[16];
#pragma unroll
    for (int r = 0; r < 16; ++r) rli[r] = __builtin_amdgcn_rcpf(li_l[crow(r, hi)]);
    const size_t ORS = (size_t)cur.rs; TOut* Ow = cur.O + (size_t)(wid * QBLK) * ORS;
    if constexpr (same_t<TOut, float>::v) {
#pragma unroll
    for (int r = 0; r < 16; ++r) { const int orow = crow(r, hi);
#pragma unroll
        for (int d0 = 0; d0 < 4; ++d0) Ow[(size_t)orow * ORS + d0 * 32 + r32] = o[d0][r] * rli[r]; }
    } else {
    bf16* stg = (bf16*)(lds + LDS_OST) + wid * 2048;
#pragma unroll
    for (int ph = 0; ph < 2; ++ph) {
#pragma unroll
        for (int r = 0; r < 16; ++r) { const int orow = crow(r, hi);
#pragma unroll
            for (int d0 = 0; d0 < 2; ++d0) stg[orow * 64 + d0 * 32 + r32] = __float2bfloat16(o[2 * ph + d0][r] * rli[r]); }
        asm volatile("s_waitcnt lgkmcnt(0)" ::: "memory");
#pragma unroll
        for (int i = 0; i < 4; ++i) { const int row = i * 8 + (lane >> 3), ch = lane & 7; const u32x4 v = *(const u32x4*)(stg + row * 64 + ch * 8); *(u32x4*)(Ow + (size_t)row * ORS + ph * 64 + ch * 8) = v; }
        asm volatile("s_waitcnt lgkmcnt(0)" ::: "memory"); }
    }
    if constexpr (F32) {
#pragma unroll
        for (int d0 = 0; d0 < 8; ++d0) S.qr[d0] = pack8(S.tq[2 * d0], S.tq[2 * d0 + 1]); }
    __syncthreads();
#undef RESC
#undef KBASE
#undef ACT
#undef MASKT
#undef SEAM_K0
#undef HALF_STEP
}
#undef ROW
#undef VMW
#undef VMWN
#undef SLOAD_H
#undef SWRITE_HK
#undef SWRITE_HV
#undef SWRITE_H
#undef SLOAD_F
#undef SWRITE_KF
#undef SWRITE_VF
}

constexpr int NWAVES = 8;
constexpr int M = 16384, SEQ = 4096, DMODEL = 2048, INW = 6144;
constexpr int NEXP = 16384;
constexpr float LN_EPS = 1e-5f;
constexpr float ALPHA = 1.189207115002721f;
constexpr float LAM_INIT = 0.2f;
constexpr int N_LAUNCHES = MK_N_LAUNCHES, PER_PHASE = 12;

constexpr size_t MiB = 1u << 20;
constexpr size_t WS_CTL = 0, CTL_ZERO_BYTES = 64 * 1024;
constexpr size_t WS_KEYS = 1 * MiB;
constexpr size_t WS_ROPEA = 1 * MiB + 512 * 1024;
constexpr size_t WS_ROPED = 2 * MiB;
constexpr size_t WS_LSE = 2 * MiB + 256 * 1024;
constexpr size_t WS_WOUT = 5 * MiB, WS_WQ = 13 * MiB, WS_WIN = 21 * MiB;
constexpr size_t WS_XN = 46 * MiB;
constexpr size_t WS_QA = 110 * MiB, WS_KA = 158 * MiB, WS_VA = 206 * MiB;
constexpr size_t WS_QD = 254 * MiB, WS_KD = 270 * MiB, WS_VD = 286 * MiB;
constexpr size_t WS_OC = 302 * MiB;
constexpr size_t WS_OD = 446 * MiB;
constexpr size_t WS_MIXED = 110 * MiB;
constexpr size_t WS_PRE = 302 * MiB;
constexpr size_t WS_H1 = 174 * MiB;
constexpr size_t WS_QP = 238 * MiB;
constexpr size_t WS_U8 = 46 * MiB, WS_V8 = 78 * MiB;
constexpr size_t WS_USC = 4608 * 1024, WS_VSC = WS_USC + 65536;
constexpr size_t WS_SX = WS_VSC + 65536;
constexpr size_t WS_SA0 = WS_SX + 65536, WS_SA1 = WS_SA0 + 65536, WS_SWI = WS_SA1 + 65536, WS_SWO = WS_SWI + 32768;
constexpr size_t WS_XN8 = 302 * MiB;
constexpr size_t WS_X8 = 110 * MiB;
constexpr size_t WS_IDX = 430 * MiB, WS_G = 438 * MiB;
constexpr size_t WS_ZP = 238 * MiB;
constexpr size_t WS_A = 366 * MiB;
constexpr size_t WS_Y = 238 * MiB;
constexpr size_t WS_END = 480 * MiB;
constexpr int CW_BAR = 4096;
constexpr size_t WS_CM = 32 * 1024;

constexpr int RING_OFF = 0, RING_BYTES = 131072;
constexpr int LDSCTL_OFF = RING_BYTES, MISC_OFF = LDSCTL_OFF + 320;
constexpr int LDS_BYTES = 147456;
static_assert(MISC_OFF + 128 <= LDS_BYTES && attn_body::ATTN_LDS_BYTES <= RING_BYTES && dil::LDS_BYTES <= RING_BYTES, "LDS map");

#define GAS __attribute__((address_space(1)))
#define LAS __attribute__((address_space(3)))
typedef unsigned short bf16;
typedef unsigned v4u __attribute__((ext_vector_type(4)));
typedef float f32x4 __attribute__((ext_vector_type(4)));
typedef float f32x2 __attribute__((ext_vector_type(2)));
typedef short bf16x8 __attribute__((ext_vector_type(8)));
typedef GAS unsigned gu32;
typedef GAS unsigned long long gu64;
#define RLX_AGENT __ATOMIC_RELAXED, __HIP_MEMORY_SCOPE_AGENT
#define LDS_WAIT() asm volatile("s_waitcnt lgkmcnt(0)" ::: "memory")
#define VM_WAIT() asm volatile("s_waitcnt vmcnt(0)" ::: "memory")
__device__ __forceinline__ unsigned long long rt() { return __builtin_amdgcn_s_memrealtime(); }
__device__ __forceinline__ unsigned f2bf(float f) { unsigned u = __builtin_bit_cast(unsigned, f); return (u + 0x7fffu + ((u >> 16) & 1u)) >> 16; }
__device__ __forceinline__ unsigned pk2(float lo, float hi) { return f2bf(lo) | (f2bf(hi) << 16); }

#define XB_TMO      128
#define XB_XCNT(j)  (256  + 64 * (j))
#define XB_XSUB(j)  (1280 + 64 * (j))
#define XB_XGEN(j)  (2304 + 64 * (j))
#define XB_TOP      3328
#define XB_TOPGEN   3392
#define XCD_BAR_WORDS 3456
#define XB_SPIN_CAP (1u << 18)

__device__ __forceinline__ unsigned xb_ld(unsigned* p)              { return __hip_atomic_load(p, __ATOMIC_RELAXED, __HIP_MEMORY_SCOPE_AGENT); }
__device__ __forceinline__ unsigned xb_add(unsigned* p, unsigned v) { return __hip_atomic_fetch_add(p, v, __ATOMIC_RELAXED, __HIP_MEMORY_SCOPE_AGENT); }
__device__ __forceinline__ unsigned xb_xcc_id() { return (unsigned)__builtin_amdgcn_s_getreg((3 << 11) | 20) & 0xFu; }
#define XB_SPIN(cond, bar) do { unsigned _sp = 0; while (cond) { __builtin_amdgcn_s_sleep(1); \
    if ((++_sp & 255u) == 0u) { if (xb_ld(&(bar)[XB_TMO])) break; if (_sp > XB_SPIN_CAP) { atomicAdd(&(bar)[XB_TMO], 1u); break; } } } } while (0)

struct XcdBarrier {
    unsigned* bar; unsigned x;
    volatile LAS unsigned* st;
};

__device__ __forceinline__ XcdBarrier xcd_barrier_post(unsigned* bar, volatile LAS unsigned* st) {
    XcdBarrier b; b.bar = bar; b.x = xb_xcc_id(); b.st = st;
    if (threadIdx.x == 0) (void)xb_add(&bar[XB_XCNT(b.x)], 1u);
    return b;
}
__device__ __forceinline__ void xcd_barrier_complete(unsigned* bar, unsigned x, unsigned& nloc, unsigned& nx) {
    const unsigned G = gridDim.x * gridDim.y * gridDim.z;
    unsigned sum, cnt, mine, sp = 0u;
    for (;;) {
        sum = 0u; cnt = 0u; mine = 0u;
#pragma unroll
        for (unsigned j = 0; j < 16; ++j) { const unsigned c = xb_ld(&bar[XB_XCNT(j)]); sum += c; cnt += (c > 0u) ? 1u : 0u; mine = (j == x) ? c : mine; }
        if (sum == G) break;
        __builtin_amdgcn_s_sleep(1);
        if ((++sp & 255u) == 0u) { if (xb_ld(&bar[XB_TMO])) break; if (sp > XB_SPIN_CAP) { atomicAdd(&bar[XB_TMO], 1u); break; } }
    }
    nloc = mine > 0u ? mine : 1u; nx = cnt > 0u ? cnt : 1u;
}

__device__ __forceinline__ void xcd_barrier(const XcdBarrier& b) {
    asm volatile("s_waitcnt vmcnt(0)" ::: "memory");
    __syncthreads();
    if (threadIdx.x == 0) {
        unsigned* bar = b.bar;
        __builtin_amdgcn_s_waitcnt(0);
        unsigned nloc = b.st[0], nx = b.st[1];
        if (nloc == 0u) { xcd_barrier_complete(bar, b.x, nloc, nx); b.st[0] = nloc; b.st[1] = nx; }
        const unsigned old = xb_add(&bar[XB_XSUB(b.x)], 1u);
        const unsigned gen = old / nloc;
        if (old + 1u == (gen + 1u) * nloc) {
            __builtin_amdgcn_fence(__ATOMIC_RELEASE, "agent");
            asm volatile("s_waitcnt vmcnt(0)" ::: "memory");
            const unsigned og = xb_add(&bar[XB_TOP], 1u);
            const unsigned tg = og / nx;
            if (og + 1u == (tg + 1u) * nx) xb_add(&bar[XB_TOPGEN], 1u);
            else XB_SPIN(xb_ld(&bar[XB_TOPGEN]) == tg, bar);
            __builtin_amdgcn_fence(__ATOMIC_ACQUIRE, "agent");
            xb_add(&bar[XB_XGEN(b.x)], 1u);
            asm volatile("s_waitcnt vmcnt(0)" ::: "memory");
        } else {
            XB_SPIN(xb_ld(&bar[XB_XGEN(b.x)]) == gen, bar);
            __builtin_amdgcn_fence(__ATOMIC_ACQUIRE, "agent");
            asm volatile("s_waitcnt vmcnt(0)" ::: "memory");
        }
    }
    __syncthreads();
}

struct Frame {
    LAS unsigned char* lds;
    volatile LAS unsigned* MISC;
    gu32* ctl;
    int tid, lane, wave;
    int vcu, G;
};
__device__ __forceinline__ float wave_sum(float v) {
#pragma unroll
    for (int o = 1; o < 64; o <<= 1) v += __shfl_xor(v, o);
    return v;
}
__device__ __forceinline__ int lane_id_fresh() { int l; asm volatile("v_mbcnt_lo_u32_b32 %0, -1, 0\n\tv_mbcnt_hi_u32_b32 %0, -1, %0" : "=v"(l)); return l; }
template <int CTRL> __device__ __forceinline__ float dpp_f(float v) { return __int_as_float(__builtin_amdgcn_update_dpp(0, __float_as_int(v), CTRL, 0xf, 0xf, true)); }
__device__ __forceinline__ float xchg32(float a, float b) { auto r = __builtin_amdgcn_permlane32_swap(__float_as_uint(a), __float_as_uint(b), false, false); return __uint_as_float(r[0]) + __uint_as_float(r[1]); }
__device__ __forceinline__ float xchg16(float a, float b) { auto r = __builtin_amdgcn_permlane16_swap(__float_as_uint(a), __float_as_uint(b), false, false); return __uint_as_float(r[0]) + __uint_as_float(r[1]); }
__device__ __forceinline__ float bflo(unsigned w) { return __uint_as_float(w << 16); }
__device__ __forceinline__ float bfhi(unsigned w) { return __uint_as_float(w & 0xffff0000u); }

__device__ __forceinline__ void p0_transpose_item(const float* W, int K, int N, bf16* WT, LAS float* scr, int item, int lane) {
    const int nblk = N / 32, kb = item / nblk, nb = item % nblk, k0 = 64 * kb, n0 = 32 * nb;
#pragma unroll 8
    for (int i = 0; i < 32; ++i) { const int kk = 2 * i + (lane >> 5); scr[kk * 33 + (lane & 31)] = __builtin_nontemporal_load(W + (size_t)(k0 + kk) * N + n0 + (lane & 31)); }
    LDS_WAIT(); asm volatile("" ::: "memory");
    const int c = lane & 7;
#pragma unroll
    for (int j = 0; j < 4; ++j) { const int n = (lane >> 3) + 8 * j; const LAS float* s = scr + (8 * c) * 33 + n;
        v4u o; o.x = pk2(s[0 * 33], s[1 * 33]); o.y = pk2(s[2 * 33], s[3 * 33]); o.z = pk2(s[4 * 33], s[5 * 33]); o.w = pk2(s[6 * 33], s[7 * 33]);
        *(GAS v4u*)(WT + (size_t)(n0 + n) * K + k0 + 8 * c) = o; }
    LDS_WAIT(); asm volatile("" ::: "memory");
}
__device__ __forceinline__ void p0_quant_item(const float* W, int N, int n0, unsigned char* WT8, float* SW, LAS unsigned char* ldsb, int tid) {
    LAS float* red = (LAS float*)ldsb;
    const int n = tid & 31;
    {
        const int c = tid & 7, r0 = tid >> 3;
        const GAS f32x4* col = (const GAS f32x4*)(W + (size_t)r0 * N + n0 + 4 * c);
        f32x4 m4 = {0.f, 0.f, 0.f, 0.f};
#pragma unroll 16
        for (int i = 0; i < 32; ++i) { const f32x4 v = col[(size_t)i * 16 * N];
            m4.x = fmaxf(m4.x, fabsf(v.x)); m4.y = fmaxf(m4.y, fabsf(v.y)); m4.z = fmaxf(m4.z, fabsf(v.z)); m4.w = fmaxf(m4.w, fabsf(v.w)); }
#pragma unroll
        for (int o = 8; o < 64; o <<= 1) { m4.x = fmaxf(m4.x, __shfl_xor(m4.x, o)); m4.y = fmaxf(m4.y, __shfl_xor(m4.y, o)); m4.z = fmaxf(m4.z, __shfl_xor(m4.z, o)); m4.w = fmaxf(m4.w, __shfl_xor(m4.w, o)); }
        if ((tid & 63) < 8) *(LAS f32x4*)(red + (tid >> 6) * 32 + 4 * c) = m4;
    }
    __syncthreads();
    if (tid < 32) { float m = 0.f;
#pragma unroll
        for (int r = 0; r < 8; ++r) m = fmaxf(m, red[r * 32 + tid]);
        red[512 + tid] = m > 0.f ? 127.f / m : 1.f; SW[n0 + tid] = m > 0.f ? m * (1.f / 127.f) : 1.f; }
    __syncthreads();
    const int lane = tid & 63, wave = tid >> 6, kh = lane >> 5;
    const float qs = red[512 + n];
    LAS unsigned char* tile = ldsb + 4096 + wave * 4608;
    for (int kt = wave; kt < 16; kt += 8) {
        const int k0 = kt * 128;
#pragma unroll 8
        for (int i = 0; i < 16; ++i) {
            const float* p = W + (size_t)(k0 + 8 * i + 4 * kh) * N + n0 + n;
            const int a0 = (int)rintf(p[0] * qs), a1 = (int)rintf(p[(size_t)N] * qs), a2 = (int)rintf(p[(size_t)2 * N] * qs), a3 = (int)rintf(p[(size_t)3 * N] * qs);
            *(LAS unsigned*)(tile + n * 144 + 8 * i + 4 * kh) = (unsigned)(a0 & 255) | ((unsigned)(a1 & 255) << 8) | ((unsigned)(a2 & 255) << 16) | ((unsigned)(a3 & 255) << 24);
        }
        LDS_WAIT(); asm volatile("" ::: "memory");
#pragma unroll
        for (int j = 0; j < 4; ++j) { const int nr = (lane >> 3) + 8 * j, c = lane & 7;
            const v4u o = *(const LAS v4u*)(tile + nr * 144 + 16 * c);
            *(GAS v4u*)(WT8 + (size_t)(n0 + nr) * 2048 + k0 + 16 * c) = o; }
        LDS_WAIT(); asm volatile("" ::: "memory");
    }
    __syncthreads();
}
__device__ __forceinline__ void p0_colmax_item(const float* W, int N, int* CM, int item, int lane) {
    const int nblk = N / 32, kb = item / nblk, nb = item % nblk, k0 = 64 * kb, n0 = 32 * nb;
    float mx = 0.f;
#pragma unroll 16
    for (int i = 0; i < 32; ++i) { const int kk = 2 * i + (lane >> 5); mx = fmaxf(mx, fabsf(__builtin_nontemporal_load(W + (size_t)(k0 + kk) * N + n0 + (lane & 31)))); }
    mx = fmaxf(mx, __shfl_xor(mx, 32));
    if (lane < 32) atomicMax(CM + n0 + lane, __float_as_int(mx));
}
__device__ __forceinline__ void wq_quant_item(const float* W, const float* CM, unsigned char* WT8, LAS unsigned char* tile, int item, int lane) {
    const int kt = item >> 6, n0 = 32 * (item & 63), k0 = kt * 64, n = lane & 31, kh = lane >> 5;
    const float cm = CM[n0 + n], qs = cm > 0.f ? 127.f / cm : 1.f;
#pragma unroll
    for (int i = 0; i < 8; ++i) {
        const float* p = W + (size_t)(k0 + 8 * i + 4 * kh) * 2048 + n0 + n;
        const int a0 = (int)rintf(p[0] * qs), a1 = (int)rintf(p[2048] * qs), a2 = (int)rintf(p[2 * 2048] * qs), a3 = (int)rintf(p[3 * 2048] * qs);
        *(LAS unsigned*)(tile + n * 80 + 8 * i + 4 * kh) = (unsigned)(a0 & 255) | ((unsigned)(a1 & 255) << 8) | ((unsigned)(a2 & 255) << 16) | ((unsigned)(a3 & 255) << 24);
    }
    LDS_WAIT(); asm volatile("" ::: "memory");
#pragma unroll
    for (int j = 0; j < 2; ++j) { const int nr = (lane >> 2) + 16 * j, c = lane & 3;
        const v4u o = *(const LAS v4u*)(tile + nr * 80 + 16 * c);
        *(GAS v4u*)(WT8 + (size_t)(n0 + nr) * 2048 + k0 + 16 * c) = o; }
    LDS_WAIT(); asm volatile("" ::: "memory");
}
__device__ __forceinline__ void ln_row_load(int lane, const float* xrow, f32x4 (&v)[8]) {
    const GAS f32x4* xr = (const GAS f32x4*)xrow + lane;
#pragma unroll
    for (int j = 0; j < 8; ++j) v[j] = __builtin_nontemporal_load(xr + 64 * j);
}
__device__ __forceinline__ void ln_row_to_bf16(int lane, f32x4 (&v)[8], const float* g, const float* b, bf16* orow, unsigned char* o8row, float* sc) {
    float s = 0.f;
#pragma unroll
    for (int j = 0; j < 8; ++j) s += (v[j].x + v[j].y) + (v[j].z + v[j].w);
    const float mean = wave_sum(s) * (1.f / DMODEL); float s2 = 0.f;
#pragma unroll
    for (int j = 0; j < 8; ++j) { v[j] = v[j] - mean; s2 += (v[j].x * v[j].x + v[j].y * v[j].y) + (v[j].z * v[j].z + v[j].w * v[j].w); }
    const float rstd = 1.f / sqrtf(wave_sum(s2) * (1.f / DMODEL) + LN_EPS);
    GAS unsigned long long* o8 = (GAS unsigned long long*)orow + lane;
    const GAS f32x4* gr = (const GAS f32x4*)g + lane; const GAS f32x4* br = (const GAS f32x4*)b + lane;
    float mx = 0.f;
#pragma unroll
    for (int j = 0; j < 8; ++j) { const f32x4 gg = gr[64 * j], bb = br[64 * j]; v[j] = v[j] * rstd * gg + bb;
        o8[64 * j] = (unsigned long long)pk2(v[j].x, v[j].y) | ((unsigned long long)pk2(v[j].z, v[j].w) << 32);
        mx = fmaxf(mx, fmaxf(fmaxf(fabsf(v[j].x), fabsf(v[j].y)), fmaxf(fabsf(v[j].z), fabsf(v[j].w)))); }
#pragma unroll
    for (int o = 1; o < 64; o <<= 1) mx = fmaxf(mx, __shfl_xor(mx, o));
    const float qs = mx > 0.f ? 127.f / mx : 1.f;
    if (lane == 0) *sc = mx > 0.f ? mx * (1.f / 127.f) : 1.f;
    GAS unsigned* x8 = (GAS unsigned*)o8row + lane;
#pragma unroll
    for (int j = 0; j < 8; ++j) { const int a0 = (int)rintf(v[j].x * qs), a1 = (int)rintf(v[j].y * qs), a2 = (int)rintf(v[j].z * qs), a3 = (int)rintf(v[j].w * qs);
        x8[64 * j] = (unsigned)(a0 & 255) | ((unsigned)(a1 & 255) << 8) | ((unsigned)(a2 & 255) << 16) | ((unsigned)(a3 & 255) << 24); }
}
__device__ __forceinline__ void cvt_chunks(const float* src, bf16* dst, size_t nchunks, int gw, int NGW, int lane) {
    for (size_t c = gw; c < nchunks; c += NGW) {
        const GAS f32x4* s = (const GAS f32x4*)(src + c * 512) + 2 * lane; const f32x4 a = s[0], b = s[1];
        v4u o; o.x = pk2(a.x, a.y); o.y = pk2(a.z, a.w); o.z = pk2(b.x, b.y); o.w = pk2(b.z, b.w);
        *((GAS v4u*)(dst + c * 512) + lane) = o; }
}
__device__ __forceinline__ float gelu_erf(float v) {
    const float av = fabsf(v), d = av * 0.2316418882f + 1.0f, t = __builtin_amdgcn_rcpf(d);
    float q = t * 0.5307027145f + (-0.7265760135f); q = q * t + 0.7107068705f; q = q * t + (-0.142248368f); q = q * t + 0.127414796f; q = q * t;
    const float e = __builtin_amdgcn_exp2f((v * v) * (-0.72134752044f));
    const float m = v * (q * e);
    return v < 0.f ? m : v - m;
}


__device__ __forceinline__ dil::BlockRef<dil::bf16, dil::bf16> dil_ref(int id, const unsigned short* QA, const unsigned short* KA, const unsigned short* VA, unsigned short* OC, float* LSE) {
    const int bh = id / 48, rest = id - bh * 48, cfg = rest >> 4, sub = rest & 15;
    const int b = bh / 12, h = bh - b * 12;
    const int r = cfg == 0 ? 1 : (cfg == 1 ? 4 : 16);
    const int nblk = 16 / r;
    const int rho = sub / nblk, n = sub - rho * nblk;
    const int P0 = n * 256;
    dil::BlockRef<dil::bf16, dil::bf16> br;
    const size_t row0 = (size_t)b * 4096 + (size_t)P0 * r + rho;
    br.Q = (const dil::bf16*)QA + row0 * 1536 + h * 128;
    br.K = (const dil::bf16*)KA + ((size_t)b * 4096 + rho) * 1536 + h * 128;
    br.V = (const dil::bf16*)VA + ((size_t)b * 4096 + rho) * 1536 + h * 128;
    br.O = (dil::bf16*)OC + (size_t)cfg * 16384 * 1536 + row0 * 1536 + h * 128;
    br.LSE = LSE + (size_t)cfg * 16384 * 12 + row0 * 12 + h;
    br.P0 = P0; br.rs = r * 1536; br.lrs = r * 12; br.skv = 4096 / r;
    return br;
}

typedef __bf16 bf16x2v __attribute__((ext_vector_type(2)));
__device__ __forceinline__ float dot2_bf16(unsigned w, unsigned x, float acc) { return __builtin_amdgcn_fdot2_f32_bf16(__builtin_bit_cast(bf16x2v, w), __builtin_bit_cast(bf16x2v, x), acc, false); }

struct Args { const float* in[19]; float* out; unsigned char* ws; int ph_lo, ph_hi, li, pad; };

__device__ __forceinline__ int fkey(float f) { const int b = __float_as_int(f); return b ^ ((b >> 31) & 0x7fffffff); }
__device__ __forceinline__ float keyf(int k) { return __int_as_float(k ^ ((k >> 31) & 0x7fffffff)); }
#define CE_DESC(a_, b_) do { const int hi__ = max(a_, b_), lo__ = min(a_, b_); a_ = hi__; b_ = lo__; } while (0)
__device__ __forceinline__ void bitonic_sort16_desc(int (&a)[16]) {
#pragma unroll
    for (int k = 2; k <= 16; k <<= 1)
#pragma unroll
        for (int j = k >> 1; j > 0; j >>= 1)
#pragma unroll
            for (int i = 0; i < 16; ++i) { const int l = i ^ j; if (l > i) { if ((i & k) == 0) CE_DESC(a[i], a[l]); else CE_DESC(a[l], a[i]); } }
}
__device__ __forceinline__ void bitonic_merge16_desc(int (&a)[16]) {
#pragma unroll
    for (int j = 8; j > 0; j >>= 1)
#pragma unroll
        for (int i = 0; i < 16; ++i) { const int l = i ^ j; if (l > i) CE_DESC(a[i], a[l]); }
}
__device__ __forceinline__ void top16_merge(int (&L)[16], const int (&B)[16]) {
#pragma unroll
    for (int i = 0; i < 16; ++i) L[i] = max(L[i], B[15 - i]);
    bitonic_merge16_desc(L);
}

__global__ void __launch_bounds__(NWAVES * 64, 2) fwd_mega(Args args) {
    extern __shared__ __attribute__((aligned(16))) unsigned char lds[];
    Frame F;
    F.lds = (LAS unsigned char*)lds;
    F.MISC = (volatile LAS unsigned*)(F.lds + MISC_OFF);
    F.tid = threadIdx.x; F.lane = F.tid & 63; F.wave = __builtin_amdgcn_readfirstlane(F.tid >> 6);
    F.G = gridDim.x; { const int bx = blockIdx.x; F.vcu = (F.G % 8 == 0) ? (bx % 8) * (F.G / 8) + bx / 8 : bx; }
    unsigned char* ws = args.ws;
    F.ctl = (gu32*)(ws + WS_CTL);
    const float* x = args.in[0]; const float* ln_emb_g = args.in[1]; const float* ln_emb_b = args.in[2]; const float* w_in = args.in[3];
    const float* dil_norm_g = args.in[4]; const float* lq1 = args.in[5]; const float* lk1 = args.in[6]; const float* lq2 = args.in[7]; const float* lk2 = args.in[8];
    const float* subln_g = args.in[9]; const float* w_out = args.in[10]; const float* ln1_g = args.in[11]; const float* ln1_b = args.in[12];
    const float* w_query = args.in[13]; const float* sub_keys = args.in[14]; const float* peer_u = args.in[15]; const float* peer_v = args.in[16];
    const float* ln2_g = args.in[17]; const float* ln2_b = args.in[18];
    float* out = args.out;
    bf16* KEYS = (bf16*)(ws + WS_KEYS); float* ROPEA = (float*)(ws + WS_ROPEA); float* ROPED = (float*)(ws + WS_ROPED); float* LSE = (float*)(ws + WS_LSE);
    unsigned char* WOUT = ws + WS_WOUT; unsigned char* WQ = ws + WS_WQ; float* CM = (float*)(ws + WS_CM); unsigned char* WIN = ws + WS_WIN; unsigned char* XN8 = ws + WS_XN8;
    float* SA0 = (float*)(ws + WS_SA0); float* SA1 = (float*)(ws + WS_SA1); float* SWI = (float*)(ws + WS_SWI); float* SWO = (float*)(ws + WS_SWO);
    bf16* XN = (bf16*)(ws + WS_XN); bf16* QA = (bf16*)(ws + WS_QA); bf16* KA = (bf16*)(ws + WS_KA); bf16* VA = (bf16*)(ws + WS_VA);
    bf16* QD = (bf16*)(ws + WS_QD); bf16* KD = (bf16*)(ws + WS_KD); bf16* VD = (bf16*)(ws + WS_VD);
    bf16* OC = (bf16*)(ws + WS_OC); bf16* OD = (bf16*)(ws + WS_OD); unsigned char* MIXED = ws + WS_MIXED; float* PRE = (float*)(ws + WS_PRE);
    bf16* H1 = (bf16*)(ws + WS_H1); bf16* QP = (bf16*)(ws + WS_QP); unsigned char* U8 = ws + WS_U8; unsigned char* V8 = ws + WS_V8; float* SC2 = (float*)(ws + WS_USC); float* SX = (float*)(ws + WS_SX); unsigned char* X8 = ws + WS_X8;
    float* ZP = (float*)(ws + WS_ZP); float* AX = (float*)(ws + WS_A); bf16* YV = (bf16*)(ws + WS_Y);
    unsigned short* IDX = (unsigned short*)(ws + WS_IDX); float* GATE = (float*)(ws + WS_G);

    for (int u = F.tid; u < (LDS_BYTES - LDSCTL_OFF) / 4; u += NWAVES * 64) ((LAS unsigned*)(F.lds + LDSCTL_OFF))[u] = 0u;
    __syncthreads();
    XcdBarrier bar; bar.bar = (unsigned*)(F.ctl + CW_BAR); bar.x = 0; bar.st = nullptr;
    if (N_LAUNCHES == 1) bar = xcd_barrier_post((unsigned*)(F.ctl + CW_BAR), F.MISC + 8);
#define GRID_BAR() do { if (N_LAUNCHES == 1) xcd_barrier(bar); } while (0)
    const int lo = args.ph_lo, hi = args.ph_hi;
#define IN(k) (lo <= (k) && (k) < hi)
#define BOTH(k) (IN(k) && IN((k) + 1))
    const int gw = F.vcu * NWAVES + F.wave, NGW = F.G * NWAVES;
    const int lane = F.lane;

    if (IN(0)) {
        LAS float* scr = (LAS float*)(F.lds + RING_OFF + F.wave * 16384);
        for (int it = F.vcu; it < INW / 32 + DMODEL / 32; it += F.G) {
            if (it < INW / 32) p0_quant_item(w_in, INW, 32 * it, WIN, SWI, F.lds + RING_OFF, F.tid);
            else p0_quant_item(w_out, DMODEL, 32 * (it - INW / 32), WOUT, SWO, F.lds + RING_OFF, F.tid);
        }
        constexpr int I_SQ = (DMODEL / 64) * (DMODEL / 32);
        for (int it = gw; it < I_SQ; it += NGW) p0_colmax_item(w_query, DMODEL, (int*)CM, it, lane);
        cvt_chunks(sub_keys, KEYS, (size_t)(8 * 2 * 128 * 128) / 512, gw, NGW, lane);
        for (int e = gw * 64 + lane; e < 4096 * 16 + 4096 * 8; e += NGW * 64) {
            int pos, i, half; float* dst;
            if (e < 4096 * 16) { pos = e >> 4; i = e & 15; half = 16; dst = ROPEA + pos * 32; }
            else { const int e2 = e - 4096 * 16; pos = e2 >> 3; i = e2 & 7; half = 8; dst = ROPED + pos * 16; }
            const float inv_freq = __builtin_amdgcn_exp2f(-(float)i / (float)half * 18.931568569324174f);
            const float ang = (float)pos * inv_freq;
            const double rev = (double)ang * 0.15915494309189535; const float fr = (float)(rev - floor(rev));
            dst[i] = __builtin_amdgcn_cosf(fr); dst[half + i] = __builtin_amdgcn_sinf(fr);
        }
        { f32x4 cur[8], nxt[8];
          if (gw < M) ln_row_load(lane, x + (size_t)gw * DMODEL, nxt);
          for (int m = gw; m < M; m += NGW) {
#pragma unroll
              for (int j = 0; j < 8; ++j) cur[j] = nxt[j];
              if (m + NGW < M) ln_row_load(lane, x + (size_t)(m + NGW) * DMODEL, nxt);
              ln_row_to_bf16(lane, cur, ln_emb_g, ln_emb_b, XN + (size_t)m * DMODEL, XN8 + (size_t)m * DMODEL, SA0 + m); } }
        if (BOTH(0)) GRID_BAR();
    }

    if (IN(1)) {
        pg8::Gemm g{XN8, WIN, M, INW, DMODEL}; pg8::StaticOrder S; S.init(M, INW, F.G, (int)blockIdx.x);
        pg8::EpiQKV E{QA, KA, VA, QD, KD, VD, ROPEA, ROPED, 0.125f * 1.4426950408889634f, SA0, SWI};
        pg8::gemm_phase<pg8::EpiQKV, pg8::StaticOrder, true, true>(F.lds + RING_OFF, g, S, E);
        if (BOTH(1)) GRID_BAR();
    }

    if (IN(2)) {
        {
            for (int U = F.vcu; U < 512; U += F.G) {
                const int combo = U >> 4, qb = U & 15;
                const int b = combo >> 3, h = (combo >> 1) & 3, map = combo & 1;
                attn_body::attn_unit<8>(b, (2 * h + map) * 64, h * 128, qb, (const attn_body::bf16*)QD, (const attn_body::bf16*)KD, (const attn_body::bf16*)VD,
                                        (attn_body::bf16*)(OD + (size_t)map * M * 512), (char*)lds + RING_OFF);
            }
        }
        __syncthreads();
        {
            using BR = dil::BlockRef<dil::bf16, dil::bf16>;
            const int total = 48 * 48;
            int L = F.vcu;
            if (L < total) {
                BR cur = dil_ref(L, QA, KA, VA, OC, LSE);
                dil::Seam<dil::bf16> Sm;
                dil::causal_swa_prime<dil::bf16, dil::bf16>(cur, 0, (char*)lds + RING_OFF, Sm);
                for (;;) {
                    const bool more = L + F.G < total;
                    const BR nxt = more ? dil_ref(L + F.G, QA, KA, VA, OC, LSE) : cur;
                    dil::causal_swa_block<dil::bf16, dil::bf16>(cur, nxt, 0, (char*)lds + RING_OFF, Sm);
                    if (!more) break;
                    cur = nxt; L += F.G;
                }
            }
        }
        if (BOTH(2)) GRID_BAR();
    }

    if (IN(3)) {
        const int lane = lane_id_fresh();
        float lam;
        { const float a1 = wave_sum(lq1[lane] * lk1[lane]), a2 = wave_sum(lq2[lane] * lk2[lane]); lam = __expf(a1) - __expf(a2) + LAM_INIT; }
        const int hl = lane >> 4, d0 = (lane & 15) * 8;
        f32x4 ga0 = *(const f32x4*)(dil_norm_g + d0), ga1 = *(const f32x4*)(dil_norm_g + d0 + 4);
        f32x4 gb0 = *(const f32x4*)(subln_g + d0) * (1.f - LAM_INIT), gb1 = *(const f32x4*)(subln_g + d0 + 4) * (1.f - LAM_INIT);
        for (int t = gw; t < M; t += NGW) {
            float r[4][8]; float mx = 0.f;
#pragma unroll
            for (int hg = 0; hg < 4; ++hg) {
                float o[8];
                if (hg < 3) {
                    const int head = hg * 4 + hl;
                    const float l0 = LSE[(size_t)t * 12 + head], l1 = LSE[(size_t)M * 12 + (size_t)t * 12 + head], l2 = LSE[(size_t)2 * M * 12 + (size_t)t * 12 + head];
                    const float mxl = fmaxf(l0, fmaxf(l1, l2)); float w0 = __expf(l0 - mxl), w1 = __expf(l1 - mxl), w2 = __expf(l2 - mxl);
                    const float inv = 1.f / (w0 + w1 + w2); w0 *= inv; w1 *= inv; w2 *= inv;
                    const size_t off = (size_t)t * 1536 + head * 128 + d0;
                    const v4u a = __builtin_nontemporal_load((const GAS v4u*)(OC + off)), b = __builtin_nontemporal_load((const GAS v4u*)(OC + (size_t)M * 1536 + off)), c = __builtin_nontemporal_load((const GAS v4u*)(OC + (size_t)2 * M * 1536 + off));
#pragma unroll
                    for (int k = 0; k < 4; ++k) { o[2 * k] = w0 * bflo(a[k]) + w1 * bflo(b[k]) + w2 * bflo(c[k]); o[2 * k + 1] = w0 * bfhi(a[k]) + w1 * bfhi(b[k]) + w2 * bfhi(c[k]); }
                } else {
                    const size_t off = (size_t)t * 512 + hl * 128 + d0;
                    const v4u a = __builtin_nontemporal_load((const GAS v4u*)(OD + off)), b = __builtin_nontemporal_load((const GAS v4u*)(OD + (size_t)M * 512 + off));
#pragma unroll
                    for (int k = 0; k < 4; ++k) { o[2 * k] = bflo(a[k]) - lam * bflo(b[k]); o[2 * k + 1] = bfhi(a[k]) - lam * bfhi(b[k]); }
                }
                float ss = 0.f;
#pragma unroll
                for (int k = 0; k < 8; ++k) ss += o[k] * o[k];
                ss += __shfl_xor(ss, 1); ss += __shfl_xor(ss, 2); ss += __shfl_xor(ss, 4); ss += __shfl_xor(ss, 8);
                const float rinv = 1.f / sqrtf(ss * (1.f / 128.f) + LN_EPS);
                const f32x4 g0 = hg < 3 ? ga0 : gb0, g1 = hg < 3 ? ga1 : gb1;
                r[hg][0] = o[0] * rinv * g0.x; r[hg][1] = o[1] * rinv * g0.y; r[hg][2] = o[2] * rinv * g0.z; r[hg][3] = o[3] * rinv * g0.w;
                r[hg][4] = o[4] * rinv * g1.x; r[hg][5] = o[5] * rinv * g1.y; r[hg][6] = o[6] * rinv * g1.z; r[hg][7] = o[7] * rinv * g1.w;
#pragma unroll
                for (int k = 0; k < 8; ++k) mx = fmaxf(mx, fabsf(r[hg][k]));
            }
#pragma unroll
            for (int o = 1; o < 64; o <<= 1) mx = fmaxf(mx, __shfl_xor(mx, o));
            const float qs = mx > 0.f ? 127.f / mx : 1.f;
            if (lane == 0) SA1[t] = mx > 0.f ? mx * (1.f / 127.f) : 1.f;
#pragma unroll
            for (int hg = 0; hg < 4; ++hg) { unsigned w[2];
#pragma unroll
                for (int k = 0; k < 2; ++k) { const int a0 = (int)rintf(r[hg][4 * k] * qs), a1 = (int)rintf(r[hg][4 * k + 1] * qs), a2 = (int)rintf(r[hg][4 * k + 2] * qs), a3 = (int)rintf(r[hg][4 * k + 3] * qs);
                    w[k] = (unsigned)(a0 & 255) | ((unsigned)(a1 & 255) << 8) | ((unsigned)(a2 & 255) << 16) | ((unsigned)(a3 & 255) << 24); }
                *(GAS unsigned long long*)(MIXED + (size_t)t * 2048 + hg * 512 + hl * 128 + d0) = (unsigned long long)w[0] | ((unsigned long long)w[1] << 32); }
        }
        if (BOTH(3)) GRID_BAR();
    }

    if (IN(4)) {
        pg8::Gemm g{MIXED, WOUT, M, DMODEL, DMODEL}; pg8::StaticOrder S; S.init(M, DMODEL, F.G, (int)blockIdx.x);
        pg8::EpiPre E{XN, PRE, ALPHA, SA1, SWO};
        pg8::gemm_phase<pg8::EpiPre, pg8::StaticOrder, true, true>(F.lds + RING_OFF, g, S, E);
        if (BOTH(4)) GRID_BAR();
    }

    if (IN(5)) {
        const int lane = lane_id_fresh();
        for (int it = gw; it < 32 * 64; it += NGW) wq_quant_item(w_query, CM, WQ, F.lds + RING_OFF + F.wave * 4608, it, lane);
        f32x4 nxt5[8];
        if (gw < M) ln_row_load(lane, PRE + (size_t)gw * DMODEL, nxt5);
        for (int m = gw; m < M; m += NGW) {
            f32x4 v[8]; float s = 0.f;
#pragma unroll
            for (int j = 0; j < 8; ++j) v[j] = nxt5[j];
            if (m + NGW < M) ln_row_load(lane, PRE + (size_t)(m + NGW) * DMODEL, nxt5);
#pragma unroll
            for (int j = 0; j < 8; ++j) s += (v[j].x + v[j].y) + (v[j].z + v[j].w);
            const float mean = wave_sum(s) * (1.f / DMODEL); float s2 = 0.f;
#pragma unroll
            for (int j = 0; j < 8; ++j) { v[j] = v[j] - mean; s2 += (v[j].x * v[j].x + v[j].y * v[j].y) + (v[j].z * v[j].z + v[j].w * v[j].w); }
            const float rstd = 1.f / sqrtf(wave_sum(s2) * (1.f / DMODEL) + LN_EPS);
            GAS unsigned long long* o8 = (GAS unsigned long long*)(H1 + (size_t)m * DMODEL) + lane;
            const GAS f32x4* gr = (const GAS f32x4*)ln1_g + lane; const GAS f32x4* br = (const GAS f32x4*)ln1_b + lane;
            float mx = 0.f;
#pragma unroll
            for (int j = 0; j < 8; ++j) { const f32x4 gg = gr[64 * j], bb = br[64 * j]; v[j] = v[j] * rstd * gg + bb;
                o8[64 * j] = (unsigned long long)pk2(v[j].x, v[j].y) | ((unsigned long long)pk2(v[j].z, v[j].w) << 32);
                mx = fmaxf(mx, fmaxf(fmaxf(fabsf(v[j].x), fabsf(v[j].y)), fmaxf(fabsf(v[j].z), fabsf(v[j].w)))); }
#pragma unroll
            for (int o = 1; o < 64; o <<= 1) mx = fmaxf(mx, __shfl_xor(mx, o));
            const float qs = mx > 0.f ? 127.f / mx : 1.f;
            if (lane == 0) SX[m] = mx > 0.f ? mx * (1.f / 127.f) : 1.f;
            GAS unsigned* x8 = (GAS unsigned*)(X8 + (size_t)m * DMODEL) + lane;
#pragma unroll
            for (int j = 0; j < 8; ++j) { const int a0 = (int)rintf(v[j].x * qs), a1 = (int)rintf(v[j].y * qs), a2 = (int)rintf(v[j].z * qs), a3 = (int)rintf(v[j].w * qs);
                x8[64 * j] = (unsigned)(a0 & 255) | ((unsigned)(a1 & 255) << 8) | ((unsigned)(a2 & 255) << 16) | ((unsigned)(a3 & 255) << 24); }
        }
        if (BOTH(5)) GRID_BAR();
    }

    if (IN(6)) {
        pg8::Gemm g{X8, WQ, M, DMODEL, DMODEL}; pg8::StaticOrder S; S.init(M, DMODEL, F.G, (int)blockIdx.x);
        pg8::EpiQP E{QP, SX, CM};
        pg8::gemm_phase<pg8::EpiQP, pg8::StaticOrder, true, true>(F.lds + RING_OFF, g, S, E);
        if (BOTH(6)) GRID_BAR();
    }

    if (IN(7)) {
        typedef float f32x16 __attribute__((ext_vector_type(16)));
        const int lane = lane_id_fresh();
        const int r32 = lane & 31, hi5 = lane >> 5;
        LAS unsigned char* kst = F.lds + RING_OFF + F.wave * 8704;
        for (int step = 0; step < 2; ++step) {
        const bool conv = (step == 0);
        if (conv) {
            for (int row0 = gw; row0 < 2 * NEXP; row0 += 2 * NGW) {
                f32x4 v[2][8];
#pragma unroll
                for (int rr = 0; rr < 2; ++rr) { const int row = row0 + rr * NGW; if (row < 2 * NEXP) {
                    const bool isv = row >= NEXP; const int e = isv ? row - NEXP : row;
                    const GAS f32x4* src = (const GAS f32x4*)((isv ? peer_v : peer_u) + (size_t)e * DMODEL) + lane;
#pragma unroll
                    for (int q = 0; q < 8; ++q) v[rr][q] = __builtin_nontemporal_load(src + 64 * q); } }
#pragma unroll
                for (int rr = 0; rr < 2; ++rr) { const int row = row0 + rr * NGW; if (row < 2 * NEXP) {
                    const bool isv = row >= NEXP; const int e = isv ? row - NEXP : row;
                    float m_ = 0.f;
#pragma unroll
                    for (int q = 0; q < 8; ++q) m_ = fmaxf(m_, fmaxf(fmaxf(fabsf(v[rr][q].x), fabsf(v[rr][q].y)), fmaxf(fabsf(v[rr][q].z), fabsf(v[rr][q].w))));
#pragma unroll
                    for (int o = 1; o < 64; o <<= 1) m_ = fmaxf(m_, __shfl_xor(m_, o));
                    const float qmax = isv ? 256.f : 127.f;
                    const float sc = m_ > 0.f ? qmax / m_ : 1.f;
                    if (lane == 0) SC2[2 * e + (isv ? 1 : 0)] = m_ > 0.f ? m_ / qmax : 1.f;
                    unsigned char* dst = (isv ? V8 : U8) + (size_t)(lane >> 5) * (NEXP * 128) + (size_t)e * 128 + 4 * (lane & 31);
#pragma unroll
                    for (int q = 0; q < 8; ++q) { const f32x4 a = v[rr][q] * sc; int p = 0;
                        if (isv) { p = __builtin_amdgcn_cvt_pk_fp8_f32(a.x, a.y, p, false); p = __builtin_amdgcn_cvt_pk_fp8_f32(a.z, a.w, p, true); }
                        else { p = (int)(((unsigned)((int)rintf(a.x) & 255)) | ((unsigned)((int)rintf(a.y) & 255) << 8) | ((unsigned)((int)rintf(a.z) & 255) << 16) | ((unsigned)((int)rintf(a.w) & 255) << 24)); }
                        *(GAS unsigned*)(dst + (size_t)(2 * q) * (NEXP * 128)) = (unsigned)p; } } }
            }
        } else {
        for (int job = gw; job < (M / 32) * 8; job += NGW) {
            const int h = job & 7, tok0 = (job >> 3) * 32;
            int la[16], lb[16];
#pragma unroll
            for (int c = 0; c < 2; ++c) {
                int L[16];
                bf16x8 bq[8];
                { const bf16* qs_ = QP + (size_t)tok0 * 2048 + h * 256 + c * 128; v4u qv[8];
#pragma unroll
                  for (int i = 0; i < 8; ++i) qv[i] = __builtin_nontemporal_load((const GAS v4u*)(qs_ + (size_t)(i * 4 + (lane >> 4)) * 2048 + (lane & 15) * 8));
#pragma unroll
                  for (int i = 0; i < 8; ++i) *(LAS v4u*)(kst + (i * 4 + (lane >> 4)) * 272 + (lane & 15) * 16) = qv[i]; }
#pragma unroll
                for (int ks = 0; ks < 8; ++ks) bq[ks] = *(const LAS bf16x8*)(kst + r32 * 272 + ks * 32 + hi5 * 16);
#pragma unroll
                for (int i = 0; i < 16; ++i) L[i] = (int)0x80000000;
#pragma unroll 1
                for (int mt = 0; mt < 4; ++mt) {
                    f32x16 acc = {};
                    { const bf16* ks_ = KEYS + (size_t)((h * 2 + c) * 128 + mt * 32) * 128; v4u kv[8];
#pragma unroll
                      for (int i = 0; i < 8; ++i) kv[i] = *(const GAS v4u*)(ks_ + (size_t)(i * 4 + (lane >> 4)) * 128 + (lane & 15) * 8);
#pragma unroll
                      for (int i = 0; i < 8; ++i) *(LAS v4u*)(kst + (i * 4 + (lane >> 4)) * 272 + (lane & 15) * 16) = kv[i]; }
#pragma unroll
                    for (int ks = 0; ks < 8; ++ks) { const bf16x8 af = *(const LAS bf16x8*)(kst + r32 * 272 + ks * 32 + hi5 * 16); acc = __builtin_amdgcn_mfma_f32_32x32x16_bf16(af, bq[ks], acc, 0, 0, 0); }
                    int B[16];
#pragma unroll
                    for (int r = 0; r < 16; ++r) { const int key = mt * 32 + (r & 3) + 8 * (r >> 2) + 4 * hi5; B[r] = (fkey(acc[r]) & ~127) | key; }
                    bitonic_sort16_desc(B);
                    top16_merge(L, B);
                }
                { int P[16];
#pragma unroll
                for (int i = 0; i < 16; ++i) P[i] = __shfl_xor(L[i], 32);
                top16_merge(L, P); }
#pragma unroll
                for (int i = 0; i < 16; ++i) { if (c == 0) la[i] = L[i]; else lb[i] = L[i]; }
            }
            float fa[16], fb[16];
#pragma unroll
            for (int i = 0; i < 16; ++i) { fa[i] = keyf(la[i] & ~127); fb[i] = keyf(lb[i] & ~127); }
            int C[16];
#pragma unroll
            for (int j = 0; j < 16; ++j) C[j] = (fkey(fa[0] + fb[j]) & ~255) | j;
#define CANDKEY(i_, j_) ((fkey(fa[i_] + fb[j_]) & ~255) | ((i_) << 4) | (j_))
            { int B[16];
              B[0] = CANDKEY(1, 0);
              B[1] = CANDKEY(1, 1);
              B[2] = CANDKEY(1, 2);
              B[3] = CANDKEY(1, 3);
              B[4] = CANDKEY(1, 4);
              B[5] = CANDKEY(1, 5);
              B[6] = CANDKEY(1, 6);
              B[7] = CANDKEY(1, 7);
              B[8] = CANDKEY(2, 0);
              B[9] = CANDKEY(2, 1);
              B[10] = CANDKEY(2, 2);
              B[11] = CANDKEY(2, 3);
              B[12] = CANDKEY(2, 4);
              B[13] = CANDKEY(3, 0);
              B[14] = CANDKEY(3, 1);
              B[15] = CANDKEY(3, 2);
              bitonic_sort16_desc(B); top16_merge(C, B); }
            { int B[16];
              B[0] = CANDKEY(3, 3);
              B[1] = CANDKEY(4, 0);
              B[2] = CANDKEY(4, 1);
              B[3] = CANDKEY(4, 2);
              B[4] = CANDKEY(5, 0);
              B[5] = CANDKEY(5, 1);
              B[6] = CANDKEY(6, 0);
              B[7] = CANDKEY(6, 1);
              B[8] = CANDKEY(7, 0);
              B[9] = CANDKEY(7, 1);
              B[10] = CANDKEY(8, 0);
              B[11] = CANDKEY(9, 0);
              B[12] = CANDKEY(10, 0);
              B[13] = CANDKEY(11, 0);
              B[14] = CANDKEY(12, 0);
              B[15] = CANDKEY(13, 0);
              bitonic_sort16_desc(B); top16_merge(C, B); }
            { int B[16];
              B[0] = CANDKEY(14, 0);
              B[1] = CANDKEY(15, 0);
              B[2] = (int)0x80000000;
              B[3] = (int)0x80000000;
              B[4] = (int)0x80000000;
              B[5] = (int)0x80000000;
              B[6] = (int)0x80000000;
              B[7] = (int)0x80000000;
              B[8] = (int)0x80000000;
              B[9] = (int)0x80000000;
              B[10] = (int)0x80000000;
              B[11] = (int)0x80000000;
              B[12] = (int)0x80000000;
              B[13] = (int)0x80000000;
              B[14] = (int)0x80000000;
              B[15] = (int)0x80000000;
              bitonic_sort16_desc(B); top16_merge(C, B); }
#undef CANDKEY
            LAS unsigned char* tab = (LAS unsigned char*)(F.lds + RING_OFF + 8 * 8704) + (F.wave * 64 + lane) * 36;
#pragma unroll
            for (int i = 0; i < 4; ++i) { ((LAS unsigned*)tab)[i] = (unsigned)(la[4 * i] & 127) | ((unsigned)(la[4 * i + 1] & 127) << 8) | ((unsigned)(la[4 * i + 2] & 127) << 16) | ((unsigned)(la[4 * i + 3] & 127) << 24);
                                          ((LAS unsigned*)tab)[4 + i] = (unsigned)(lb[4 * i] & 127) | ((unsigned)(lb[4 * i + 1] & 127) << 8) | ((unsigned)(lb[4 * i + 2] & 127) << 16) | ((unsigned)(lb[4 * i + 3] & 127) << 24); }
            int ex[16];
#pragma unroll
            for (int k = 0; k < 16; ++k) { const int ci = (C[k] >> 4) & 15, cj = C[k] & 15; ex[k] = (int)tab[ci] * 128 + (int)tab[16 + cj]; }
            const float s0 = keyf(C[0] & ~255); float e[16]; float den = 0.f;
#pragma unroll
            for (int k = 0; k < 16; ++k) { e[k] = __expf(keyf(C[k] & ~255) - s0); den += e[k]; }
            const float rden = 1.f / den;
            if (hi5 == 0) {
                unsigned short* ip = IDX + (size_t)(tok0 + r32) * 128 + h * 16; float* gp = GATE + (size_t)(tok0 + r32) * 128 + h * 16;
                v4u i0_, i1_;
                i0_.x = (unsigned)ex[0] | ((unsigned)ex[1] << 16); i0_.y = (unsigned)ex[2] | ((unsigned)ex[3] << 16); i0_.z = (unsigned)ex[4] | ((unsigned)ex[5] << 16); i0_.w = (unsigned)ex[6] | ((unsigned)ex[7] << 16);
                i1_.x = (unsigned)ex[8] | ((unsigned)ex[9] << 16); i1_.y = (unsigned)ex[10] | ((unsigned)ex[11] << 16); i1_.z = (unsigned)ex[12] | ((unsigned)ex[13] << 16); i1_.w = (unsigned)ex[14] | ((unsigned)ex[15] << 16);
                *(GAS v4u*)ip = i0_; *(GAS v4u*)(ip + 8) = i1_;
#pragma unroll
                for (int k = 0; k < 16; k += 4) *(f32x4*)(gp + k) = (f32x4){e[k] * rden, e[k + 1] * rden, e[k + 2] * rden, e[k + 3] * rden};
            }
        }
        }
        }
        if (BOTH(7)) GRID_BAR();
    }

    if (IN(8)) {
        const int lane = lane_id_fresh();
        const int g = lane >> 3, c = lane & 7, b0 = c & 1, b1 = (c >> 1) & 1, b2 = (c >> 2) & 1;
        const int label = blockIdx.x & 7, member = blockIdx.x >> 3, nmem = (F.G + 7 - label) >> 3, st = nmem * 8;
        const int i0 = 8 * b2 + 4 * b0 + 2 * b1;
#define PU_IDX(T) do { const GAS v4u* ip_ = (const GAS v4u*)(IDX + (unsigned)((T) * 128 + 16 * g)); _Pragma("unroll") for (int i = 0; i < 2; ++i) { const v4u v_ = ip_[i]; _Pragma("unroll") for (int q = 0; q < 4; ++q) { en[8 * i + 2 * q] = (int)(v_[q] & 0xffffu); en[8 * i + 2 * q + 1] = (int)(v_[q] >> 16); } } } while (0)
#define PU_ROWS(BUF, XA, XB, T) do { _Pragma("unroll") for (int i = 0; i < 16; ++i) BUF[i] = *(const GAS v4u*)(U8s + (unsigned)(en[i] * 128)); \
            XA = __builtin_nontemporal_load((const GAS v4u*)(X8 + (unsigned)((T) * 2048 + soff))); } while (0)
#define PU_COMP(BUF, XA, XB, T) do { \
            float pz[16]; \
            _Pragma("unroll") for (int i = 0; i < 16; ++i) { int acc = 0; \
                _Pragma("unroll") for (int q = 0; q < 4; ++q) acc = __builtin_amdgcn_sdot4((int)BUF[i][q], (int)XA[q], acc, false); \
                pz[i] = (float)acc; } \
            float q8[8], q4[4], q2[2]; \
            _Pragma("unroll") for (int j = 0; j < 8; ++j) { const float keep = b2 ? pz[j + 8] : pz[j], send = b2 ? pz[j] : pz[j + 8]; q8[j] = keep + dpp_f<0x141>(send); } \
            _Pragma("unroll") for (int j = 0; j < 4; ++j) { const float keep = b0 ? q8[j + 4] : q8[j], send = b0 ? q8[j] : q8[j + 4]; q4[j] = keep + dpp_f<0xB1>(send); } \
            _Pragma("unroll") for (int j = 0; j < 2; ++j) { const float keep = b1 ? q4[j + 2] : q4[j], send = b1 ? q4[j] : q4[j + 2]; q2[j] = keep + dpp_f<0x4E>(send); } \
            __builtin_nontemporal_store((f32x2){q2[0], q2[1]}, (GAS f32x2*)(ZP + ((size_t)s * M + (T)) * 128 + 16 * g + i0)); } while (0)
        for (int p = 0; p < 2; ++p) {
            const int s = label * 2 + p; const int soff = 128 * s + 16 * c;
            const unsigned char* U8s = U8 + (size_t)s * (NEXP * 128) + 16 * c;
            int t = member * 8 + F.wave;
            int en[16]; v4u bA[16], bB[16]; v4u xA0, xA1, xB0, xB1;
            if (t < M) { PU_IDX(t); PU_ROWS(bA, xA0, xA1, t); if (t + st < M) PU_IDX(t + st); }
            for (; t < M; t += 2 * st) {
                if (t + st < M) { PU_ROWS(bB, xB0, xB1, t + st); if (t + 2 * st < M) PU_IDX(t + 2 * st); }
                PU_COMP(bA, xA0, xA1, t);
                if (t + st < M) {
                    if (t + 2 * st < M) { PU_ROWS(bA, xA0, xA1, t + 2 * st); if (t + 3 * st < M) PU_IDX(t + 3 * st); }
                    PU_COMP(bB, xB0, xB1, t + st);
                }
            }
        }
#undef PU_ROWS
#undef PU_COMP
        if (BOTH(8)) GRID_BAR();
    }
    if (IN(9)) {
        for (size_t i = ((size_t)blockIdx.x * 512 + F.tid) * 4; i < (size_t)M * 128; i += (size_t)F.G * 512 * 4) {
            f32x4 z = {0.f, 0.f, 0.f, 0.f};
#pragma unroll
            for (int s = 0; s < 16; ++s) z = z + __builtin_nontemporal_load((const GAS f32x4*)(ZP + (size_t)s * M * 128 + i));
            const uint2 e2_ = *(const uint2*)(IDX + i); const v4u e = {e2_.x & 0xffffu, e2_.x >> 16, e2_.y & 0xffffu, e2_.y >> 16}; const f32x4 gt = *(const GAS f32x4*)(GATE + i); const float sx = SX[i >> 7];
            f32x4 a;
            const f32x2 s0_ = *(const GAS f32x2*)(SC2 + 2 * e.x), s1_ = *(const GAS f32x2*)(SC2 + 2 * e.y), s2_ = *(const GAS f32x2*)(SC2 + 2 * e.z), s3_ = *(const GAS f32x2*)(SC2 + 2 * e.w);
            a.x = gt.x * gelu_erf(z.x * s0_.x * sx) * s0_.y; a.y = gt.y * gelu_erf(z.y * s1_.x * sx) * s1_.y;
            a.z = gt.z * gelu_erf(z.z * s2_.x * sx) * s2_.y; a.w = gt.w * gelu_erf(z.w * s3_.x * sx) * s3_.y;
            *(GAS f32x4*)(AX + i) = a;
        }
        if (BOTH(9)) GRID_BAR();
    }
    if (IN(10)) {
        const int lane = lane_id_fresh();
        const int g = lane >> 3, c = lane & 7, b3 = g & 1, b4 = (g >> 1) & 1, b5 = (g >> 2) & 1;
        const int label = blockIdx.x & 7, member = blockIdx.x >> 3, nmem = (F.G + 7 - label) >> 3, st = nmem * 8;
        const int j0 = 8 * b5 + 4 * b4 + 2 * b3;
#define PV_ROWS(BUF, AA, HH, T) do { _Pragma("unroll") for (int i = 0; i < 16; ++i) BUF[i] = *(const GAS v4u*)(V8s + (unsigned)(en[i] * 128)); \
            const GAS f32x4* ap_ = (const GAS f32x4*)(AX + (unsigned)((T) * 128 + 16 * g)); _Pragma("unroll") for (int i = 0; i < 4; ++i) { const f32x4 v_ = ap_[i]; AA[4 * i] = v_.x; AA[4 * i + 1] = v_.y; AA[4 * i + 2] = v_.z; AA[4 * i + 3] = v_.w; } \
            HH = __builtin_nontemporal_load((const GAS unsigned*)(H1 + (unsigned)((T) * 2048 + soff + j0))); } while (0)
#define PV_COMP(BUF, AA, HH, T) do { f32x2 y2[8]; \
            _Pragma("unroll") for (int m = 0; m < 8; ++m) y2[m] = (f32x2){0.f, 0.f}; \
            _Pragma("unroll") for (int i = 0; i < 16; ++i) { const f32x2 a2 = {AA[i], AA[i]}; \
                _Pragma("unroll") for (int q = 0; q < 4; ++q) { const int w = (int)BUF[i][q]; const f32x2 lo = __builtin_amdgcn_cvt_pk_f32_fp8(w, false), hi = __builtin_amdgcn_cvt_pk_f32_fp8(w, true); \
                    y2[2 * q] = __builtin_elementwise_fma(lo, a2, y2[2 * q]); y2[2 * q + 1] = __builtin_elementwise_fma(hi, a2, y2[2 * q + 1]); } } \
            float y[16]; _Pragma("unroll") for (int m = 0; m < 8; ++m) { y[2 * m] = y2[m].x; y[2 * m + 1] = y2[m].y; } \
            float q8[8], q4[4], q2[2]; \
            _Pragma("unroll") for (int j = 0; j < 8; ++j) q8[j] = xchg32(y[j], y[j + 8]); \
            _Pragma("unroll") for (int j = 0; j < 4; ++j) q4[j] = xchg16(q8[j], q8[j + 4]); \
            _Pragma("unroll") for (int j = 0; j < 2; ++j) { const float keep = b3 ? q4[j + 2] : q4[j], send = b3 ? q4[j] : q4[j + 2]; q2[j] = keep + dpp_f<0x128>(send); } \
            __builtin_nontemporal_store(pk2(q2[0] + ALPHA * bflo(HH), q2[1] + ALPHA * bfhi(HH)), (GAS unsigned*)(YV + (unsigned)((T) * 2048 + soff + j0))); } while (0)
        for (int p = 0; p < 2; ++p) {
            const int s = label * 2 + p; const int soff = 128 * s + 16 * c;
            const unsigned char* V8s = V8 + (size_t)s * (NEXP * 128) + 16 * c;
            int t = member * 8 + F.wave;
            int en[16]; v4u bA[16], bB[16]; float aA[16], aB[16]; unsigned hA, hB;
            if (t < M) { PU_IDX(t); PV_ROWS(bA, aA, hA, t); if (t + st < M) PU_IDX(t + st); }
            for (; t < M; t += 2 * st) {
                if (t + st < M) { PV_ROWS(bB, aB, hB, t + st); if (t + 2 * st < M) PU_IDX(t + 2 * st); }
                PV_COMP(bA, aA, hA, t);
                if (t + st < M) {
                    if (t + 2 * st < M) { PV_ROWS(bA, aA, hA, t + 2 * st); if (t + 3 * st < M) PU_IDX(t + 3 * st); }
                    PV_COMP(bB, aB, hB, t + st);
                }
            }
        }
#undef PV_ROWS
#undef PV_COMP
#undef PU_IDX
        if (BOTH(10)) GRID_BAR();
    }
    if (IN(11)) {
        const int lane = lane_id_fresh();
        unsigned long long nx11[8];
        if (gw < M) { const GAS unsigned long long* hr = (const GAS unsigned long long*)(YV + (size_t)gw * 2048) + lane;
#pragma unroll
            for (int j = 0; j < 8; ++j) nx11[j] = __builtin_nontemporal_load(hr + 64 * j); }
        for (int m = gw; m < M; m += NGW) {
            unsigned long long hc[8];
#pragma unroll
            for (int j = 0; j < 8; ++j) hc[j] = nx11[j];
            if (m + NGW < M) { const GAS unsigned long long* hr = (const GAS unsigned long long*)(YV + (size_t)(m + NGW) * 2048) + lane;
#pragma unroll
                for (int j = 0; j < 8; ++j) nx11[j] = __builtin_nontemporal_load(hr + 64 * j); }
            f32x4 v[8]; float s = 0.f;
#pragma unroll
            for (int j = 0; j < 8; ++j) { const unsigned long long h = hc[j]; const unsigned hl = (unsigned)h, hh = (unsigned)(h >> 32);
                v[j] = (f32x4){bflo(hl), bfhi(hl), bflo(hh), bfhi(hh)}; s += (v[j].x + v[j].y) + (v[j].z + v[j].w); }
            const float mean = wave_sum(s) * (1.f / DMODEL); float s2 = 0.f;
#pragma unroll
            for (int j = 0; j < 8; ++j) { v[j] = v[j] - mean; s2 += (v[j].x * v[j].x + v[j].y * v[j].y) + (v[j].z * v[j].z + v[j].w * v[j].w); }
            const float rstd = 1.f / sqrtf(wave_sum(s2) * (1.f / DMODEL) + LN_EPS);
            const GAS f32x4* gr = (const GAS f32x4*)ln2_g + lane; const GAS f32x4* br = (const GAS f32x4*)ln2_b + lane;
            GAS f32x4* orow = (GAS f32x4*)(out + (size_t)m * 2048) + lane;
#pragma unroll
            for (int j = 0; j < 8; ++j) __builtin_nontemporal_store(v[j] * rstd * gr[64 * j] + br[64 * j], orow + 64 * j);
        }
    }
#undef IN
#undef BOTH
#undef GRID_BAR
}


extern "C" void kernel_launch(void* const* d_in, const int* in_sizes, int n_in, void* d_out, int out_size, void* d_ws, size_t ws_size, hipStream_t stream) {
    static int grid = 0;
    if (grid == 0) {
        if (n_in != 19 || in_sizes[0] != M * DMODEL || out_size != M * DMODEL || ws_size < WS_END) {
            fprintf(stderr, "kernel_launch: shape/workspace mismatch (n_in %d, in0 %d, out %d, ws %zu; need ws >= %zu); nothing launched\n", n_in, n_in > 0 ? in_sizes[0] : -1, out_size, ws_size, (size_t)WS_END); grid = -1; return; }
        int dev = 0, cus = 0, per_cu = 0;
        if (hipGetDevice(&dev) != hipSuccess || hipDeviceGetAttribute(&cus, hipDeviceAttributeMultiprocessorCount, dev) != hipSuccess) { fprintf(stderr, "kernel_launch: device query failed\n"); grid = -1; return; }
        if (hipFuncSetAttribute((const void*)fwd_mega, hipFuncAttributeMaxDynamicSharedMemorySize, LDS_BYTES) != hipSuccess) { fprintf(stderr, "kernel_launch: hipFuncSetAttribute failed\n"); grid = -1; return; }
        if (hipOccupancyMaxActiveBlocksPerMultiprocessor(&per_cu, (const void*)fwd_mega, NWAVES * 64, LDS_BYTES) != hipSuccess || per_cu < 1)
            fprintf(stderr, "kernel_launch: note: occupancy query reports %d workgroups per CU\n", per_cu);
        (void)hipGetLastError();
        grid = cus;
        if (grid != 256) fprintf(stderr, "kernel_launch: note: %d CUs (tuned for 256)\n", grid);
    }
    if (grid < 0) return;
    if (hipMemsetAsync((char*)d_ws + WS_CTL, 0, CTL_ZERO_BYTES, stream) != hipSuccess) { fprintf(stderr, "kernel_launch: memset failed\n"); return; }
    Args a{};
    for (int i = 0; i < 19; ++i) a.in[i] = (const float*)d_in[i];
    a.out = (float*)d_out; a.ws = (unsigned char*)d_ws;
    if (N_LAUNCHES == 1) { a.ph_lo = 0; a.ph_hi = MK_PHASE_HI; a.li = 0; hipLaunchKernelGGL(fwd_mega, dim3(grid), dim3(NWAVES * 64), LDS_BYTES, stream, a); }
    else { for (int li = 0; li < MK_PHASE_HI; ++li) { a.ph_lo = li; a.ph_hi = li + 1; a.li = li; hipLaunchKernelGGL(fwd_mega, dim3(grid), dim3(NWAVES * 64), LDS_BYTES, stream, a);
        } }
    const hipError_t le = hipPeekAtLastError();
    if (le != hipSuccess) fprintf(stderr, "kernel_launch: launch failed: %s\n", hipGetErrorName(le));
}
```

```cpp
#include <hip/hip_runtime.h>
#include <hip/hip_bf16.h>
#include <cstdio>
#include <cstdint>
#include <cmath>

#ifndef MK_N_LAUNCHES
#define MK_N_LAUNCHES 1
#endif
#ifndef MK_PHASE_HI
#define MK_PHASE_HI 12
#endif

__device__ __forceinline__ int tid_fresh() { int t_; asm volatile("v_mov_b32 %0, %1" : "=v"(t_) : "v"((int)threadIdx.x)); return t_; }
namespace pg8 {
#define PG8_LAS __attribute__((address_space(3)))
typedef unsigned short bf16_t;
typedef short bf16x8 __attribute__((ext_vector_type(8)));
typedef float f32x4 __attribute__((ext_vector_type(4)));
typedef unsigned u32x4 __attribute__((ext_vector_type(4)));
typedef int i32x4 __attribute__((ext_vector_type(4)));
template <bool B, class T, class F> struct cond_t { typedef T type; };
template <class T, class F> struct cond_t<false, T, F> { typedef F type; };
__device__ __forceinline__ f32x4 mma1(bf16x8 a, bf16x8 b, f32x4 c) { return __builtin_amdgcn_mfma_f32_16x16x32_bf16(a, b, c, 0, 0, 0); }
__device__ __forceinline__ i32x4 mma1(bf16x8 a, bf16x8 b, i32x4 c) { return __builtin_amdgcn_mfma_i32_16x16x64_i8(__builtin_bit_cast(i32x4, a), __builtin_bit_cast(i32x4, b), c, 0, 0, 0); }
constexpr int BM = 256, BK = 64, HALF = 128, HTB = HALF * BK * 2  , STAGE_BYTES = 8 * HTB, NXCD = 8, WGM = 8;

__host__ __device__ __forceinline__ int lds_byte(int r, int c) { const int st = (r >> 4) * 2 + (c >> 5), rr = r & 15, cc = c & 31, ob = rr * 64 + cc * 2; return st * 1024 + (ob ^ (((ob >> 9) & 1) << 5)); }
__host__ __device__ __forceinline__ void stage_rc(int b, int& R, int& C) { const int st = b / 1024, sb = b % 1024, swz = sb ^ (((sb >> 9) & 1) << 5); R = (st >> 1) * 16 + swz / 64; C = (st & 1) * 32 + (swz % 64) / 2; }
__host__ __device__ __forceinline__ int perm32(int rho) { const int n = rho >> 4, i = rho & 15; return 8 * (i >> 2) + 4 * n + (i & 3); }

struct Unit { int pm, pn; };
struct Gemm { const void* A; const void* Bt; int M, N, K; };

struct StaticOrder {
    int nM, nN, nwg, G, c;
    __host__ __device__ void init(int M, int N, int G_, int c_) { nM = M / BM; nN = N / BM; nwg = nM * nN; G = G_; c = c_; }
    __host__ __device__ bool next(int i, Unit& u) const {
        const long L = (long)i * G + c; if (L >= nwg) return false;
        int wgid = (int)L; { const int q = nwg / NXCD, r = nwg % NXCD, xcd = wgid % NXCD, off = wgid / NXCD; wgid = (xcd < r ? xcd * (q + 1) : r * (q + 1) + (xcd - r) * q) + off; }
        const int nig = WGM * nN, gid = wgid / nig, fm = gid * WGM, gsz = (nM - fm) < WGM ? (nM - fm) : WGM;
        u.pm = fm + ((wgid % nig) % gsz); u.pn = (wgid % nig) / gsz; return true;
    }
    __device__ __forceinline__ void a_ready(const Unit&) const {}
    __device__ __forceinline__ void done(const Unit&) const {}
};

__device__ __forceinline__ unsigned cvt_pk_bf16(float lo, float hi) { unsigned r; asm volatile("v_cvt_pk_bf16_f32 %0, %1, %2" : "=v"(r) : "v"(lo), "v"(hi)); return r; }

template <int ACT  > struct EpiBf16 {
    static constexpr bool PERM = true, AFTER_DRAIN = false, I8 = false; static_assert(ACT == 0 || ACT == 1, "EpiBf16: ACT is 0 (none) or 1 (gelu_pk)");
    bf16_t* O; int ldc; const float* bias; int split_cols; size_t split_stride; float scale0;
    __device__ __forceinline__ void operator()(const f32x4 (&acc)[2][2][4][2], const Unit& u, int wr, int wc, int fr, int fq) const {
        const int row0 = u.pm * BM + wr * 64 + fr; int colt = u.pn * BM; bf16_t* base = O;
        float sc = 1.f; if (split_cols) { const int t = colt / split_cols; base += (size_t)t * split_stride; colt -= t * split_cols; if (t == 0) sc = scale0; }
        const int col0 = colt + wc * 32 + 8 * fq, bcol0 = u.pn * BM + wc * 32 + 8 * fq;
        f32x4 bv[2][2];
#pragma unroll
        for (int bj = 0; bj < 2; ++bj)
#pragma unroll
            for (int n = 0; n < 2; ++n) bv[bj][n] = bias ? *(const f32x4*)(bias + bcol0 + bj * HALF + 4 * n) : (f32x4){0.f, 0.f, 0.f, 0.f};
#pragma unroll
        for (int ai = 0; ai < 2; ++ai)
#pragma unroll
            for (int m = 0; m < 4; ++m) { bf16_t* rowp = base + (size_t)(row0 + ai * HALF + m * 16) * ldc + col0;
#pragma unroll
                for (int bj = 0; bj < 2; ++bj) { f32x4 v0 = acc[ai][bj][m][0] + bv[bj][0], v1 = acc[ai][bj][m][1] + bv[bj][1];
                    v0 = v0 * sc; v1 = v1 * sc; u32x4 w; w.x = cvt_pk_bf16(v0[0], v0[1]); w.y = cvt_pk_bf16(v0[2], v0[3]); w.z = cvt_pk_bf16(v1[0], v1[1]); w.w = cvt_pk_bf16(v1[2], v1[3]);
                    *(u32x4*)(rowp + bj * HALF) = w; } }
    }
};

__device__ __forceinline__ f32x4 shx4(f32x4 v, int mask) { f32x4 r; r[0] = __shfl_xor(v[0], mask); r[1] = __shfl_xor(v[1], mask); r[2] = __shfl_xor(v[2], mask); r[3] = __shfl_xor(v[3], mask); return r; }
struct EpiQKV {
    static constexpr bool PERM = true, AFTER_DRAIN = false, I8 = true;
    bf16_t *QA, *KA, *VA, *QD, *KD, *VD;
    const float* ropeA;
    const float* ropeD;
    float qd_scale;
    const float* sa;
    const float* sw;
    __device__ __forceinline__ void operator()(const i32x4 (&acc)[2][2][4][2], const Unit& u, int wr, int wc, int fr, int fq) const {
        const int pn = u.pn;
        bf16_t* base; int ldc, colt, kind; float sc = 1.f;
        if (pn < 6)       { base = QA; ldc = 1536; colt = pn * 256;        kind = 1; }
        else if (pn < 12) { base = KA; ldc = 1536; colt = (pn - 6) * 256;  kind = 1; }
        else if (pn < 18) { base = VA; ldc = 1536; colt = (pn - 12) * 256; kind = 0; }
        else if (pn < 20) { base = QD; ldc = 512;  colt = (pn - 18) * 256; kind = 2; sc = qd_scale; }
        else if (pn < 22) { base = KD; ldc = 512;  colt = (pn - 20) * 256; kind = 2; }
        else              { base = VD; ldc = 512;  colt = (pn - 22) * 256; kind = 0; }
        const int row0 = u.pm * BM + wr * 64 + fr, col0 = colt + wc * 32 + 8 * fq, wcol0 = pn * BM + wc * 32 + 8 * fq;
        const bool ra = (kind == 1) && (wc == 0);
        const bool rd = (kind == 2) && ((wc & 1) == 0);
        f32x4 w0[2], w1[2];
#pragma unroll
        for (int bj = 0; bj < 2; ++bj) { w0[bj] = *(const f32x4*)(sw + wcol0 + bj * HALF) * sc; w1[bj] = *(const f32x4*)(sw + wcol0 + bj * HALF + 4) * sc; }
#pragma unroll
        for (int ai = 0; ai < 2; ++ai)
#pragma unroll
            for (int m = 0; m < 4; ++m) {
                const int row = row0 + ai * HALF + m * 16, pos = row & 4095;
                const float sr = sa[row];
                f32x4 c0 = {1.f, 1.f, 1.f, 1.f}, c1 = c0, s0 = {0.f, 0.f, 0.f, 0.f}, s1 = s0;
                if (ra) { const float* t = ropeA + pos * 32 + 8 * (fq & 1); c0 = *(const f32x4*)t; c1 = *(const f32x4*)(t + 4); s0 = *(const f32x4*)(t + 16); s1 = *(const f32x4*)(t + 20);
                          if (fq < 2) { s0 = -s0; s1 = -s1; } }
                if (rd) { if (fq < 2) { const float* t = ropeD + pos * 16; c0 = *(const f32x4*)t; c1 = *(const f32x4*)(t + 4); s0 = *(const f32x4*)(t + 8); s1 = *(const f32x4*)(t + 12);
                          if (fq == 0) { s0 = -s0; s1 = -s1; } } }
                bf16_t* rowp = base + (size_t)row * ldc + col0;
#pragma unroll
                for (int bj = 0; bj < 2; ++bj) {
                    f32x4 v0 = __builtin_convertvector(acc[ai][bj][m][0], f32x4) * (w0[bj] * sr), v1 = __builtin_convertvector(acc[ai][bj][m][1], f32x4) * (w1[bj] * sr);
                    if (ra) { const f32x4 p0 = shx4(v0, 32), p1 = shx4(v1, 32); v0 = v0 * c0 + p0 * s0; v1 = v1 * c1 + p1 * s1; }
                    if (rd) { const f32x4 p0 = shx4(v0, 16), p1 = shx4(v1, 16); v0 = v0 * c0 + p0 * s0; v1 = v1 * c1 + p1 * s1; }
                    u32x4 w; w.x = cvt_pk_bf16(v0[0], v0[1]); w.y = cvt_pk_bf16(v0[2], v0[3]); w.z = cvt_pk_bf16(v1[0], v1[1]); w.w = cvt_pk_bf16(v1[2], v1[3]);
                    *(u32x4*)(rowp + bj * HALF) = w; }
            }
    }
};
struct EpiPre {
    static constexpr bool PERM = true, AFTER_DRAIN = false, I8 = true;
    const bf16_t* H0; bf16_t* PRE; float alpha;
    const float* sa;
    const float* sw;
    __device__ __forceinline__ void operator()(const i32x4 (&acc)[2][2][4][2], const Unit& u, int wr, int wc, int fr, int fq) const {
        const int row0 = u.pm * BM + wr * 64 + fr, col0 = u.pn * BM + wc * 32 + 8 * fq;
        f32x4 w0[2], w1[2];
#pragma unroll
        for (int bj = 0; bj < 2; ++bj) { w0[bj] = *(const f32x4*)(sw + col0 + bj * HALF); w1[bj] = *(const f32x4*)(sw + col0 + bj * HALF + 4); }
#pragma unroll
        for (int ai = 0; ai < 2; ++ai)
#pragma unroll
            for (int m = 0; m < 4; ++m) { const int row = row0 + ai * HALF + m * 16; const size_t off = (size_t)row * 2048 + col0; const float sr = sa[row];
#pragma unroll
                for (int bj = 0; bj < 2; ++bj) { const size_t o = off + bj * HALF;
                    const u32x4 h = *(const u32x4*)(H0 + o);
                    const f32x4 h0 = {__uint_as_float(h.x << 16), __uint_as_float(h.x & 0xffff0000u), __uint_as_float(h.y << 16), __uint_as_float(h.y & 0xffff0000u)};
                    const f32x4 h1 = {__uint_as_float(h.z << 16), __uint_as_float(h.z & 0xffff0000u), __uint_as_float(h.w << 16), __uint_as_float(h.w & 0xffff0000u)};
                    const f32x4 v0 = h0 * alpha + __builtin_convertvector(acc[ai][bj][m][0], f32x4) * (w0[bj] * sr), v1 = h1 * alpha + __builtin_convertvector(acc[ai][bj][m][1], f32x4) * (w1[bj] * sr);
                    u32x4 w; w.x = cvt_pk_bf16(v0[0], v0[1]); w.y = cvt_pk_bf16(v0[2], v0[3]); w.z = cvt_pk_bf16(v1[0], v1[1]); w.w = cvt_pk_bf16(v1[2], v1[3]);
                    *(u32x4*)(PRE + o) = w; } }
    }
};

struct EpiQP {
    static constexpr bool PERM = true, AFTER_DRAIN = false, I8 = true;
    bf16_t* O; const float* sa; const float* cm;
    __device__ __forceinline__ void operator()(const i32x4 (&acc)[2][2][4][2], const Unit& u, int wr, int wc, int fr, int fq) const {
        const int row0 = u.pm * BM + wr * 64 + fr, col0 = u.pn * BM + wc * 32 + 8 * fq;
        f32x4 w0[2], w1[2];
#pragma unroll
        for (int bj = 0; bj < 2; ++bj) { w0[bj] = *(const f32x4*)(cm + col0 + bj * HALF) * (1.f / 127.f); w1[bj] = *(const f32x4*)(cm + col0 + bj * HALF + 4) * (1.f / 127.f); }
#pragma unroll
        for (int ai = 0; ai < 2; ++ai)
#pragma unroll
            for (int m = 0; m < 4; ++m) { const int row = row0 + ai * HALF + m * 16; const float sr = sa[row]; bf16_t* rowp = O + (size_t)row * 2048 + col0;
#pragma unroll
                for (int bj = 0; bj < 2; ++bj) { const f32x4 v0 = __builtin_convertvector(acc[ai][bj][m][0], f32x4) * (w0[bj] * sr), v1 = __builtin_convertvector(acc[ai][bj][m][1], f32x4) * (w1[bj] * sr);
                    u32x4 w; w.x = cvt_pk_bf16(v0[0], v0[1]); w.y = cvt_pk_bf16(v0[2], v0[3]); w.z = cvt_pk_bf16(v1[0], v1[1]); w.w = cvt_pk_bf16(v1[2], v1[3]);
                    *(u32x4*)(rowp + bj * HALF) = w; } }
    }
};

template <class Epi, class Sched, bool ALIGN_EPI = false, bool SP2 = false>
__device__ __forceinline__ void gemm_phase(PG8_LAS unsigned char* lds, const Gemm g, const Sched& S, const Epi& E) {
    const int tid = threadIdx.x, wid = __builtin_amdgcn_readfirstlane(tid >> 6), lane = tid & 63, wr = wid >> 2, wc = wid & 3, fr = lane & 15, fq = lane >> 4;
    constexpr bool I8 = Epi::I8; typedef typename cond_t<I8, i32x4, f32x4>::type acc_t;
    const int K = I8 ? g.K / 2 : g.K, nt = K / BK;
    unsigned voffA[2], voffB[2];
#pragma unroll
    for (int i = 0; i < 2; ++i) { int R, C; stage_rc(tid * 16 + i * 8192, R, C); const int Rb = Epi::PERM ? ((R & ~31) + perm32(R & 31)) : R;
        voffA[i] = (unsigned)(R * K + C) * 2u; voffB[i] = (unsigned)(Rb * K + C) * 2u; }
    const size_t kstep = (size_t)(BK * 2);
    const size_t hstep = (size_t)HALF * K * 2;
    const size_t tstep = 2 * hstep;
    const unsigned ldsw = (unsigned)wid * 1024u;
    const int aoff = lds_byte(wr * 64 + fr, fq * 8), boff = lds_byte(wc * 32 + fr, fq * 8);
#define PG8_SA(b, h) (((b) * 2 + (h)) * HTB)
#define PG8_SB(b, h) ((4 + (b) * 2 + (h)) * HTB)
#define PG8_STAGE(bufoff, gbase, voff) do { _Pragma("unroll") for (int _i = 0; _i < 2; ++_i) \
        __builtin_amdgcn_global_load_lds((const unsigned*)((const char*)(gbase) + (voff)[_i]), (PG8_LAS unsigned*)(lds + (bufoff) + ldsw + _i * 8192), 16, 0, 0); } while (0)
#define PG8_LDA(dst, b, h) do { _Pragma("unroll") for (int m = 0; m < 4; ++m) _Pragma("unroll") for (int k = 0; k < 2; ++k) dst[m][k] = *(const PG8_LAS bf16x8*)(lds + PG8_SA(b, h) + aoff + m * 2048 + k * 1024); } while (0)
#define PG8_LDB(dst, b, h) do { _Pragma("unroll") for (int n = 0; n < 2; ++n) _Pragma("unroll") for (int k = 0; k < 2; ++k) dst[n][k] = *(const PG8_LAS bf16x8*)(lds + PG8_SB(b, h) + boff + n * 2048 + k * 1024); } while (0)
#define PG8_MMA(ai, bj, At, Bt) do { __builtin_amdgcn_s_setprio(1); _Pragma("unroll") for (int m = 0; m < 4; ++m) _Pragma("unroll") for (int n = 0; n < 2; ++n) _Pragma("unroll") for (int k = 0; k < 2; ++k) \
        acc[ai][bj][m][n] = mma1(Bt[n][k], At[m][k], acc[ai][bj][m][n]); __builtin_amdgcn_s_setprio(0); } while (0)
#define PG8_WAIT_V(n) asm volatile("s_waitcnt vmcnt(" #n ")" ::: "memory")
#define PG8_WAIT_L(n) asm volatile("s_waitcnt lgkmcnt(" #n ")" ::: "memory")
#define PG8_BAR __builtin_amdgcn_s_barrier()
#define PG8_SCHED __builtin_amdgcn_sched_barrier(0)
    Unit cur, nxt; int ui = 0;
    if (!S.next(0, cur)) return;
    acc_t acc[2][2][4][2];
#pragma unroll
    for (int a = 0; a < 2; ++a)
#pragma unroll
        for (int b = 0; b < 2; ++b)
#pragma unroll
            for (int m = 0; m < 4; ++m)
#pragma unroll
                for (int n = 0; n < 2; ++n) acc[a][b][m][n] = acc_t{};
    bf16x8 At[4][2], B0[2][2], B1[2][2];
    const char* cA = (const char*)g.A + (size_t)cur.pm * tstep; const char* cB = (const char*)g.Bt + (size_t)cur.pn * tstep;
    S.a_ready(cur);
    if constexpr (SP2) {
        PG8_STAGE(PG8_SB(0, 0), cB, voffB); PG8_STAGE(PG8_SB(0, 1), cB + hstep, voffB); PG8_STAGE(PG8_SA(0, 0), cA, voffA); PG8_STAGE(PG8_SA(0, 1), cA + hstep, voffA);
        if (wr == 1) PG8_BAR;
        PG8_WAIT_V(2); PG8_BAR;
        PG8_STAGE(PG8_SB(1, 0), cB + kstep, voffB); PG8_STAGE(PG8_SA(1, 0), cA + kstep, voffA); PG8_STAGE(PG8_SB(1, 1), cB + hstep + kstep, voffB);
        PG8_WAIT_V(6); PG8_BAR;
    } else {
        PG8_STAGE(PG8_SB(0, 0), cB, voffB); PG8_STAGE(PG8_SA(0, 0), cA, voffA); PG8_STAGE(PG8_SB(0, 1), cB + hstep, voffB); PG8_STAGE(PG8_SA(0, 1), cA + hstep, voffA);
        if (wr == 1) PG8_BAR;
        PG8_WAIT_V(4); PG8_BAR;
        PG8_STAGE(PG8_SB(1, 0), cB + kstep, voffB); PG8_STAGE(PG8_SA(1, 0), cA + kstep, voffA); PG8_STAGE(PG8_SB(1, 1), cB + hstep + kstep, voffB);
        PG8_WAIT_V(6); PG8_BAR;
    }
    for (;;) {
        const bool has_next = S.next(ui + 1, nxt);
        const char* nA = has_next ? (const char*)g.A + (size_t)nxt.pm * tstep : cA; const char* nB = has_next ? (const char*)g.Bt + (size_t)nxt.pn * tstep : cB;
        for (int t = 0; t < nt; t += 2) {
            const bool last = (t == nt - 2);
            const char* a1 = cA + (size_t)(t + 1) * kstep;
            const char* a2 = last ? nA : cA + (size_t)(t + 2) * kstep; const char* b2 = last ? nB : cB + (size_t)(t + 2) * kstep;
            const char* a3 = a2 + kstep; const char* b3 = b2 + kstep;
            if (last && has_next) S.a_ready(nxt);
            if constexpr (SP2) {
            PG8_LDB(B0, 0, 0); PG8_LDB(B1, 0, 1); PG8_SCHED; PG8_LDA(At, 0, 0); PG8_STAGE(PG8_SA(1, 1), a1 + hstep, voffA);
            PG8_WAIT_V(8); PG8_WAIT_L(0); PG8_BAR; PG8_MMA(0, 0, At, B0); PG8_MMA(0, 1, At, B1); PG8_BAR; PG8_SCHED;
            PG8_LDA(At, 0, 1); PG8_STAGE(PG8_SB(0, 0), b2, voffB); PG8_STAGE(PG8_SB(0, 1), b2 + hstep, voffB); PG8_STAGE(PG8_SA(0, 0), a2, voffA);
            PG8_WAIT_V(8); PG8_WAIT_L(0); PG8_BAR; PG8_MMA(1, 0, At, B0); PG8_MMA(1, 1, At, B1); PG8_BAR; PG8_SCHED;
            PG8_LDB(B0, 1, 0); PG8_LDB(B1, 1, 1); PG8_SCHED; PG8_LDA(At, 1, 0); PG8_STAGE(PG8_SA(0, 1), a2 + hstep, voffA);
            PG8_WAIT_V(8); PG8_WAIT_L(0); PG8_BAR; PG8_MMA(0, 0, At, B0); PG8_MMA(0, 1, At, B1); PG8_BAR; PG8_SCHED;
            PG8_LDA(At, 1, 1); PG8_STAGE(PG8_SB(1, 0), b3, voffB); PG8_STAGE(PG8_SB(1, 1), b3 + hstep, voffB); PG8_STAGE(PG8_SA(1, 0), a3, voffA);
            PG8_WAIT_V(8); PG8_WAIT_L(0); PG8_BAR; PG8_MMA(1, 0, At, B0); PG8_MMA(1, 1, At, B1); PG8_BAR; PG8_SCHED;
            } else {
            PG8_LDB(B0, 0, 0); PG8_SCHED; PG8_LDA(At, 0, 0); PG8_STAGE(PG8_SA(1, 1), a1 + hstep, voffA);
            PG8_WAIT_L(8); PG8_BAR; PG8_WAIT_L(0); PG8_MMA(0, 0, At, B0); PG8_BAR; PG8_SCHED;
            PG8_LDB(B1, 0, 1); PG8_STAGE(PG8_SB(0, 0), b2, voffB);
            PG8_BAR; PG8_WAIT_L(0); PG8_MMA(0, 1, At, B1); PG8_BAR;
            PG8_LDA(At, 0, 1); PG8_STAGE(PG8_SA(0, 0), a2, voffA);
            PG8_BAR; PG8_WAIT_L(0); PG8_MMA(1, 0, At, B0); PG8_BAR; PG8_SCHED;
            PG8_STAGE(PG8_SB(0, 1), b2 + hstep, voffB);
            PG8_WAIT_V(6); PG8_BAR; PG8_MMA(1, 1, At, B1); PG8_BAR;
            PG8_LDB(B0, 1, 0); PG8_SCHED; PG8_LDA(At, 1, 0); PG8_STAGE(PG8_SA(0, 1), a2 + hstep, voffA);
            PG8_WAIT_L(8); PG8_BAR; PG8_WAIT_L(0); PG8_MMA(0, 0, At, B0); PG8_BAR; PG8_SCHED;
            PG8_LDB(B1, 1, 1); PG8_STAGE(PG8_SB(1, 0), b3, voffB);
            PG8_BAR; PG8_WAIT_L(0); PG8_MMA(0, 1, At, B1); PG8_BAR;
            PG8_LDA(At, 1, 1); PG8_STAGE(PG8_SA(1, 0), a3, voffA);
            PG8_BAR; PG8_WAIT_L(0); PG8_MMA(1, 0, At, B0); PG8_BAR; PG8_SCHED;
            PG8_STAGE(PG8_SB(1, 1), b3 + hstep, voffB);
            PG8_WAIT_V(6); PG8_BAR; PG8_MMA(1, 1, At, B1); PG8_BAR;
            }
        }
        if constexpr (ALIGN_EPI) { if (wr == 0) PG8_BAR; }
        if constexpr (!Epi::AFTER_DRAIN) { E(acc, cur, wr, wc, fr, fq); S.done(cur); }
        if (!has_next) break;
#pragma unroll
        for (int a = 0; a < 2; ++a)
#pragma unroll
            for (int b = 0; b < 2; ++b)
#pragma unroll
                for (int m = 0; m < 4; ++m)
#pragma unroll
                    for (int n = 0; n < 2; ++n) acc[a][b][m][n] = acc_t{};
        cur = nxt; cA = nA; cB = nB; ++ui;
        if constexpr (ALIGN_EPI) { if (wr == 1) PG8_BAR; }
    }
    PG8_WAIT_V(0);
    if constexpr (!ALIGN_EPI) { if (wr == 0) PG8_BAR; }
    PG8_BAR;
    if constexpr (Epi::AFTER_DRAIN) { E.fused(acc, cur, wr, wc, fr, fq, lds, wid, lane); S.done(cur); }
#undef PG8_SA
#undef PG8_SB
#undef PG8_STAGE
#undef PG8_LDA
#undef PG8_LDB
#undef PG8_MMA
#undef PG8_WAIT_V
#undef PG8_WAIT_L
#undef PG8_BAR
#undef PG8_SCHED
}
}

#include <hip/hip_bf16.h>
#include <cmath>
namespace attn_body {
using bf16=__hip_bfloat16;
using bf16x8=__attribute__((ext_vector_type(8)))short;
using s16x4=__attribute__((ext_vector_type(4)))short;
using f32x16=__attribute__((ext_vector_type(16)))float;
using u32x4=__attribute__((ext_vector_type(4)))unsigned;
constexpr int SEQ=4096,D=64,DM=512;
constexpr int NW=8,QBLK=32,QB=QBLK*NW,KVBLK=64,NQB=SEQ/QB;
constexpr int ATTN_PITCH=DM, ATTN_UNIT_ROWS=QB;
__device__ __forceinline__ int crow(int r,int hi){return (r&3)+8*(r>>2)+4*hi;}
#define SBAR() __builtin_amdgcn_sched_barrier(0)
__device__ __forceinline__ void cmask(f32x16&p0,f32x16&p1,int jb,int qrel,int hi){
  const float NEG=-INFINITY; int kb=64*jb+4*hi;
  #pragma unroll
  for(int r=0;r<16;++r){int kv=kb+(r&3)+8*(r>>2); if(kv>qrel)p0[r]=NEG; if(kv+32>qrel)p1[r]=NEG;}
}

constexpr int NSLOT=3, SLOTB=8192;
constexpr int LDS_K=0, LDS_V=NSLOT*SLOTB, LDS_V2=2*NSLOT*SLOTB, LDS_WS=3*NSLOT*SLOTB, LDS_OST=LDS_WS+NW*64*4, LDS_BYTES=LDS_OST+NW*4096;
constexpr float C2=0.125f*1.4426950408889634f;
__device__ __forceinline__ void glds16(const void*gsrc,unsigned lds_dst){unsigned keep;
  asm volatile("s_mov_b32 %0, m0\n\ts_mov_b32 m0, %2\n\ts_nop 0\n\tglobal_load_lds_dwordx4 %1, off\n\ts_mov_b32 m0, %0":"=&s"(keep):"v"(gsrc),"s"(lds_dst):"memory");}
__device__ __forceinline__ float max3f(float a,float b,float c){float r;asm("v_max3_f32 %0, %1, %2, %3":"=v"(r):"v"(a),"v"(b),"v"(c));return r;}
__device__ __forceinline__ float max2f(float a,float b){float r;asm("v_max_f32_e32 %0, %1, %2":"=v"(r):"v"(a),"v"(b));return r;}
__device__ __forceinline__ float fadd_s(float a,float b){float r;asm("v_add_f32_e32 %0, %1, %2":"=v"(r):"v"(a),"v"(b));return r;}
__device__ __forceinline__ float fsub_s(float a,float b){float r;asm("v_sub_f32_e32 %0, %1, %2":"=v"(r):"v"(a),"v"(b));return r;}
typedef float f32x2_t __attribute__((ext_vector_type(2))); typedef __bf16 bf16x2_t __attribute__((ext_vector_type(2)));
__device__ __forceinline__ unsigned cvtpk_s(float lo,float hi){f32x2_t v={lo,hi};bf16x2_t b=__builtin_convertvector(v,bf16x2_t);return __builtin_bit_cast(unsigned,b);}
#define WAIT_BAR(N) asm volatile("s_waitcnt vmcnt(" #N ") lgkmcnt(0)\n\ts_barrier":::"memory")

__device__ __forceinline__ void qkt(f32x16&p0,f32x16&p1,const char*Kslot,const bf16x8*qr,const f32x16&negm,int r32,int hi){
  const char*kb=Kslot+hi*1024+r32*16;
  #pragma unroll
  for(int d0=0;d0<4;++d0){
    const bf16x8 b0=*reinterpret_cast<const bf16x8*>(kb+d0*2048);
    const bf16x8 b1=*reinterpret_cast<const bf16x8*>(kb+d0*2048+512);
    if(d0==0){p0=__builtin_amdgcn_mfma_f32_32x32x16_bf16(b0,qr[0],negm,0,0,0);p1=__builtin_amdgcn_mfma_f32_32x32x16_bf16(b1,qr[0],negm,0,0,0);}
    else{p0=__builtin_amdgcn_mfma_f32_32x32x16_bf16(b0,qr[d0],p0,0,0,0);p1=__builtin_amdgcn_mfma_f32_32x32x16_bf16(b1,qr[d0],p1,0,0,0);}}
}
typedef __attribute__((address_space(3))) const char* lds_cptr;
typedef short v4i16_t __attribute__((ext_vector_type(4)));
__device__ __forceinline__ void kload8(bf16x8*kf,lds_cptr kp){
  kf[0]=*(const __attribute__((address_space(3))) bf16x8*)(kp);      kf[1]=*(const __attribute__((address_space(3))) bf16x8*)(kp+512);
  kf[2]=*(const __attribute__((address_space(3))) bf16x8*)(kp+2048); kf[3]=*(const __attribute__((address_space(3))) bf16x8*)(kp+2560);
  kf[4]=*(const __attribute__((address_space(3))) bf16x8*)(kp+4096); kf[5]=*(const __attribute__((address_space(3))) bf16x8*)(kp+4608);
  kf[6]=*(const __attribute__((address_space(3))) bf16x8*)(kp+6144); kf[7]=*(const __attribute__((address_space(3))) bf16x8*)(kp+6656);
}
__device__ __forceinline__ void kload2(bf16x8*kf,lds_cptr kp,int j){ kf[2*j]=*(const __attribute__((address_space(3))) bf16x8*)(kp+j*2048); kf[2*j+1]=*(const __attribute__((address_space(3))) bf16x8*)(kp+j*2048+512); }
__device__ __forceinline__ s16x4 vtr(lds_cptr p){ return __builtin_bit_cast(s16x4,__builtin_amdgcn_ds_read_tr16_b64_v4i16((__attribute__((address_space(3))) v4i16_t*)p)); }
__device__ __forceinline__ float rowmax(const f32x16&p0,const f32x16&p1){
  float a=max3f(p0[0],p0[1],p1[0]),b=max3f(p0[2],p0[3],p1[1]);a=max3f(a,p1[2],p1[3]);
  #pragma unroll
  for(int r=4;r<16;r+=4){a=max3f(a,p0[r],p0[r+1]);b=max3f(b,p0[r+2],p0[r+3]);a=max3f(a,p1[r],p1[r+1]);b=max3f(b,p1[r+2],p1[r+3]);}
  const float m=max2f(a,b);
  auto rr=__builtin_amdgcn_permlane32_swap(__float_as_uint(m),__float_as_uint(m),false,false);
  return max2f(__uint_as_float(rr[0]),__uint_as_float(rr[1]));
}
__device__ __forceinline__ void pv(f32x16*o,int vb,bf16x8 pa0,bf16x8 pa1,bf16x8 pa2,bf16x8 pa3){
  #pragma unroll
  for(int d0=0;d0<2;++d0){s16x4 lo[4],hi[4];
    #pragma unroll
    for(int ks=0;ks<4;++ks){
      asm volatile("ds_read_b64_tr_b16 %0,%1 offset:%c2":"=&v"(lo[ks]):"v"(vb),"i"(d0*4096+ks*1024):"memory");
      asm volatile("ds_read_b64_tr_b16 %0,%1 offset:%c2":"=&v"(hi[ks]):"v"(vb),"i"(d0*4096+ks*1024+512):"memory");}
    asm volatile("s_waitcnt lgkmcnt(0)":::"memory");SBAR();
    #define PK(k) (bf16x8){lo[k][0],lo[k][1],lo[k][2],lo[k][3],hi[k][0],hi[k][1],hi[k][2],hi[k][3]}
    o[d0]=__builtin_amdgcn_mfma_f32_32x32x16_bf16(pa0,PK(0),o[d0],0,0,0);
    o[d0]=__builtin_amdgcn_mfma_f32_32x32x16_bf16(pa1,PK(1),o[d0],0,0,0);
    o[d0]=__builtin_amdgcn_mfma_f32_32x32x16_bf16(pa2,PK(2),o[d0],0,0,0);
    o[d0]=__builtin_amdgcn_mfma_f32_32x32x16_bf16(pa3,PK(3),o[d0],0,0,0);
    #undef PK
  }
}

#ifndef ATTN_STORE16
#define ATTN_STORE16(p,v) (*(u32x4*)(p)=(v))
#endif
template<int THRL> __device__ __forceinline__ void attn_unit(int b,int cqk,int cvo,int qb,const bf16*Q,const bf16*__restrict__ K,const bf16*__restrict__ V,bf16*O,char*shm){
  const int tid=tid_fresh(),lane=tid&63,r32=lane&31,hi=lane>>5; const int wid=__builtin_amdgcn_readfirstlane(tid>>6);
  const long rowbase=(long)b*SEQ; const int q0=qb*QB;
  const bf16*Qw=Q+(rowbase+q0+wid*QBLK)*DM+cqk;
  const bf16*Kh=K+rowbase*DM+cqk,*Vh=V+rowbase*DM+cvo;
  const unsigned lds0=(unsigned)(uintptr_t)shm;
  float*wsf=(float*)(shm+LDS_WS)+wid*64;
  const bf16*ksrc=Kh+(long)lane*DM+wid*8;
  const bf16*vsrc=Vh+(long)(16*(wid&3)+(lane>>2))*DM+(wid>>2)*32+(lane&3)*8;
  const unsigned kdst=lds0+LDS_K+wid*1024, vdst=lds0+LDS_V+wid*1024, vdst2=lds0+LDS_V2+wid*1024;
  #define DMA_K(t,slot) glds16(ksrc+(long)(t)*KVBLK*DM,(unsigned)__builtin_amdgcn_readfirstlane(kdst+(slot)))
  #define DMA_V(t,slot) do{ glds16(vsrc+(long)(t)*KVBLK*DM,(unsigned)__builtin_amdgcn_readfirstlane(vdst+(slot))); glds16(vsrc+64+(long)(t)*KVBLK*DM,(unsigned)__builtin_amdgcn_readfirstlane(vdst2+(slot))); }while(0)
  const int vb0=(int)(lds0+LDS_V)+((lane>>4)&1)*32+(lane&3)*8+(4*hi+((lane&15)>>2))*64;
  const char*Kbase=shm+LDS_K; bf16x8 kf[8];
  const lds_cptr shm3=(lds_cptr)shm; const lds_cptr kp0=shm3+LDS_K+hi*1024+r32*16; const lds_cptr vp0=shm3+LDS_V+((lane>>4)&1)*32+(lane&3)*8+(4*hi+((lane&15)>>2))*64;
  const int NT=SEQ/KVBLK;
  DMA_K(0,0);DMA_V(0,0);DMA_K(1,SLOTB);
  bf16x8 qr[4];
  #pragma unroll
  for(int d0=0;d0<4;++d0)qr[d0]=*reinterpret_cast<const bf16x8*>(&Qw[(long)r32*DM+d0*16+hi*8]);
  float mhat=0.f,l_reg=0.f;f32x16 o[4];o[0]=f32x16{};o[1]=f32x16{};o[2]=f32x16{};o[3]=f32x16{};const f32x16 zero16=f32x16{};
  const int qrel=wid*QBLK+r32; (void)qrel;
  #define CMASK(P0,P1,t) do{}while(0)
  bool resc=false;
  #define START(P0,P1) do{ const float rm=rowmax(P0,P1); resc=false; \
    { const float dl=rm; mhat=fadd_s(mhat,dl); \
      _Pragma("unroll") for(int r=0;r<16;++r){P0[r]=fsub_s(P0[r],dl);P1[r]=fsub_s(P1[r],dl);} \
      } \
    _Pragma("unroll") for(int r=0;r<16;++r)P0[r]=__builtin_amdgcn_exp2f(P0[r]); }while(0)
  #define RESC() do{ if(resc){ asm volatile("s_waitcnt lgkmcnt(0)":::"memory"); \
      _Pragma("unroll") for(int d_=0;d_<4;++d_) _Pragma("unroll") for(int r=0;r<16;++r)o[d_][r]*=wsf[crow(r,hi)]; } }while(0)
  f32x16 pA0,pA1,pB0,pB1;
  int sl_prev=0,sl_cur=0,sl_next=SLOTB;
  #define ROT() do{sl_prev=sl_cur;sl_cur=sl_next;sl_next=(sl_next==(NSLOT-1)*SLOTB)?0:sl_next+SLOTB;}while(0)
  DMA_K(2,2*SLOTB);
  WAIT_BAR(4);
  qkt(pA0,pA1,Kbase,qr,zero16,r32,hi);asm volatile("s_nop 15\n\ts_nop 7":"+v"(pA0),"+v"(pA1));CMASK(pA0,pA1,0);
  START(pA0,pA1);
  _Pragma("unroll") for(int r=0;r<16;++r)pA1[r]=__builtin_amdgcn_exp2f(pA1[r]);
  WAIT_BAR(0);
  DMA_K(3,0);DMA_V(1,SLOTB);
  ROT();
  kload8(kf,kp0+sl_cur);
  WAIT_BAR(3);
  s16x4 vlo[8],vhi[8]; u32x4 pw0,pw1,pw2,pw3;
  #define PKW(P,B) cvtpk_s(P[B],P[B+1])
  #define PAF(k) __builtin_bit_cast(bf16x8,pw##k)
  #define VFR(i) (bf16x8){vlo[i][0],vlo[i][1],vlo[i][2],vlo[i][3],vhi[i][0],vhi[i][1],vhi[i][2],vhi[i][3]}
  #define PIN(x) asm volatile("":"+v"(x))
  #define MX3(a,b,c) __builtin_fmaxf(__builtin_fmaxf((a),(b)),(c))
  #define GAPA(MF,A0,A1,A2,A3,W0,W1,PW) do{ MF; sacc+=A0; sacc+=A1; sacc+=A2; sacc+=A3; PIN(sacc); W0; W1; PIN(PW); SBAR(); }while(0)
  #define EX(v) __builtin_amdgcn_exp2f(v)
  #define GAPB(MF,X,B) do{ MF; X[B]=EX(X[B]); X[B+1]=EX(X[B+1]); X[B+2]=EX(X[B+2]); X[B+3]=EX(X[B+3]); PIN(X); SBAR(); }while(0)
  #define VRD(i) do{ vlo[i]=vtr(vp_+(((i)>>2)*4096+((i)&3)*1024)); vhi[i]=vtr(vp_+(((i)>>2)*4096+((i)&3)*1024+512)); }while(0)
  #define KRD(G,j) do{ if(G){ kload2(kf,kp0+sl_next,j); SBAR(); } }while(0)
  #define STEP(C0,C1,P0,P1,t,GK,GV,GL) do{ SBAR(); \
    const lds_cptr vp_=vp0+sl_prev; \
    VRD(0); SBAR(); float sacc=(P0[0]+P0[1]); \
    GAPA(C0=__builtin_amdgcn_mfma_f32_32x32x16_bf16(kf[0],qr[0],zero16,0,0,0), P0[2],P0[3],P0[4],P0[5],     pw0[0]=PKW(P0,0), pw0[1]=PKW(P0,2), pw0); \
    VRD(4); SBAR(); GAPA(C1=__builtin_amdgcn_mfma_f32_32x32x16_bf16(kf[1],qr[0],zero16,0,0,0), P0[6],P0[7],P0[8],P0[9],     pw0[2]=PKW(P0,4), pw0[3]=PKW(P0,6), pw0); \
    VRD(1); SBAR(); GAPA(C0=__builtin_amdgcn_mfma_f32_32x32x16_bf16(kf[2],qr[1],C0,0,0,0),   P0[10],P0[11],P0[12],P0[13], pw1[0]=PKW(P0,8), pw1[1]=PKW(P0,10), pw1); \
    VRD(5); SBAR(); GAPA(C1=__builtin_amdgcn_mfma_f32_32x32x16_bf16(kf[3],qr[1],C1,0,0,0),   P0[14],P0[15],P1[0],P1[1],   pw1[2]=PKW(P0,12),pw1[3]=PKW(P0,14), pw1); \
    VRD(2); SBAR(); GAPA(C0=__builtin_amdgcn_mfma_f32_32x32x16_bf16(kf[4],qr[2],C0,0,0,0),   P1[2],P1[3],P1[4],P1[5],     pw2[0]=PKW(P1,0), pw2[1]=PKW(P1,2), pw2); \
    VRD(6); SBAR(); GAPA(C1=__builtin_amdgcn_mfma_f32_32x32x16_bf16(kf[5],qr[2],C1,0,0,0),   P1[6],P1[7],P1[8],P1[9],     pw2[2]=PKW(P1,4), pw2[3]=PKW(P1,6), pw2); \
    VRD(3); SBAR(); GAPA(C0=__builtin_amdgcn_mfma_f32_32x32x16_bf16(kf[6],qr[3],C0,0,0,0),   P1[10],P1[11],P1[12],P1[13], pw3[0]=PKW(P1,8), pw3[1]=PKW(P1,10), pw3); \
    VRD(7); SBAR(); GAPA(C1=__builtin_amdgcn_mfma_f32_32x32x16_bf16(kf[7],qr[3],C1,0,0,0),   P1[14],P1[15],0.f,0.f,       pw3[2]=PKW(P1,12),pw3[3]=PKW(P1,14), pw3); \
    l_reg+=sacc; \
    if(GK){DMA_K((t)+3,sl_cur);} if(GV){DMA_V((t)+1,sl_next);} \
    CMASK(C0,C1,t); \
    _Pragma("unroll") for(int r=0;r<16;++r){C0[r]-=mhat;C1[r]-=mhat;} \
    { float a=MX3(C0[0],C0[1],C1[0]),b=MX3(C0[2],C0[3],C1[1]); a=MX3(a,C1[2],C1[3]); \
      _Pragma("unroll") for(int r=4;r<16;r+=4){a=MX3(a,C0[r],C0[r+1]);b=MX3(b,C0[r+2],C0[r+3]);a=MX3(a,C1[r],C1[r+1]);b=MX3(b,C1[r+2],C1[r+3]);} \
      float rm=__builtin_fmaxf(a,b); { auto rr=__builtin_amdgcn_permlane32_swap(__float_as_uint(rm),__float_as_uint(rm),false,false); rm=__builtin_fmaxf(__uint_as_float(rr[0]),__uint_as_float(rr[1])); } \
      resc=false; \
      if(__builtin_expect(__any(rm>(float)THRL),0)){ const float dl=__builtin_fmaxf(rm,0.f); mhat+=dl; \
        _Pragma("unroll") for(int r=0;r<16;++r){C0[r]-=dl;C1[r]-=dl;} \
        const float f=__builtin_amdgcn_exp2f(-dl); l_reg*=f; if(hi==0)wsf[r32]=f; resc=true; } } \
    SBAR(); \
    GAPB(o[0]=__builtin_amdgcn_mfma_f32_32x32x16_bf16(PAF(0),VFR(0),o[0],0,0,0), C0,0); \
    GAPB(o[1]=__builtin_amdgcn_mfma_f32_32x32x16_bf16(PAF(0),VFR(4),o[1],0,0,0), C0,4); \
    KRD(GL,0); GAPB(o[0]=__builtin_amdgcn_mfma_f32_32x32x16_bf16(PAF(1),VFR(1),o[0],0,0,0), C0,8); \
    KRD(GL,1); GAPB(o[1]=__builtin_amdgcn_mfma_f32_32x32x16_bf16(PAF(1),VFR(5),o[1],0,0,0), C0,12); \
    KRD(GL,2); GAPB(o[0]=__builtin_amdgcn_mfma_f32_32x32x16_bf16(PAF(2),VFR(2),o[0],0,0,0), C1,0); \
    KRD(GL,3); GAPB(o[1]=__builtin_amdgcn_mfma_f32_32x32x16_bf16(PAF(2),VFR(6),o[1],0,0,0), C1,4); \
    GAPB(o[0]=__builtin_amdgcn_mfma_f32_32x32x16_bf16(PAF(3),VFR(3),o[0],0,0,0), C1,8); \
    GAPB(o[1]=__builtin_amdgcn_mfma_f32_32x32x16_bf16(PAF(3),VFR(7),o[1],0,0,0), C1,12); \
      \
    { const lds_cptr vq_=vp0+(LDS_V2-LDS_V)+sl_prev; \
      _Pragma("unroll") for(int i_=0;i_<8;++i_){ vlo[i_]=vtr(vq_+((i_>>2)*4096+(i_&3)*1024)); vhi[i_]=vtr(vq_+((i_>>2)*4096+(i_&3)*1024+512)); } \
      o[2]=__builtin_amdgcn_mfma_f32_32x32x16_bf16(PAF(0),VFR(0),o[2],0,0,0); o[3]=__builtin_amdgcn_mfma_f32_32x32x16_bf16(PAF(0),VFR(4),o[3],0,0,0); \
      o[2]=__builtin_amdgcn_mfma_f32_32x32x16_bf16(PAF(1),VFR(1),o[2],0,0,0); o[3]=__builtin_amdgcn_mfma_f32_32x32x16_bf16(PAF(1),VFR(5),o[3],0,0,0); \
      o[2]=__builtin_amdgcn_mfma_f32_32x32x16_bf16(PAF(2),VFR(2),o[2],0,0,0); o[3]=__builtin_amdgcn_mfma_f32_32x32x16_bf16(PAF(2),VFR(6),o[3],0,0,0); \
      o[2]=__builtin_amdgcn_mfma_f32_32x32x16_bf16(PAF(3),VFR(3),o[2],0,0,0); o[3]=__builtin_amdgcn_mfma_f32_32x32x16_bf16(PAF(3),VFR(7),o[3],0,0,0); SBAR(); } \
    }while(0)
  int t=1;
  #undef CMASK
  #define CMASK(P0,P1,t) do{}while(0)
  for(;t+5<NT;t+=2){
    STEP(pB0,pB1,pA0,pA1,t,true,true,true);     WAIT_BAR(3); RESC(); ROT();
    STEP(pA0,pA1,pB0,pB1,t+1,true,true,true);   WAIT_BAR(3); RESC(); ROT();
  }
  #undef CMASK
  #define CMASK(P0,P1,t) do{}while(0)
  #define ENDW(tt) do{ if((tt)+3<NT){WAIT_BAR(3);} else if((tt)+2<NT){WAIT_BAR(2);} else {WAIT_BAR(0);} }while(0)
  for(;t+1<NT;t+=2){
    STEP(pB0,pB1,pA0,pA1,t,(t+3<NT),(t+1<NT),(t+1<NT));       ENDW(t);   RESC(); ROT();
    STEP(pA0,pA1,pB0,pB1,t+1,(t+4<NT),(t+2<NT),(t+2<NT));     ENDW(t+1); RESC(); ROT();
  }
  STEP(pB0,pB1,pA0,pA1,NT-1,false,false,false); RESC();
  { float sacc=pB0[0]+pB0[1]; _Pragma("unroll") for(int r=2;r<16;++r)sacc+=pB0[r]; _Pragma("unroll") for(int r=0;r<16;++r)sacc+=pB1[r]; l_reg+=sacc;
    pw0=(u32x4){PKW(pB0,0),PKW(pB0,2),PKW(pB0,4),PKW(pB0,6)};pw1=(u32x4){PKW(pB0,8),PKW(pB0,10),PKW(pB0,12),PKW(pB0,14)};pw2=(u32x4){PKW(pB1,0),PKW(pB1,2),PKW(pB1,4),PKW(pB1,6)};pw3=(u32x4){PKW(pB1,8),PKW(pB1,10),PKW(pB1,12),PKW(pB1,14)};
    SBAR(); pv(o,vb0+sl_cur,PAF(0),PAF(1),PAF(2),PAF(3)); pv(o+2,vb0+(LDS_V2-LDS_V)+sl_cur,PAF(0),PAF(1),PAF(2),PAF(3)); }
  #undef PKW
  #undef PAF
  #undef VFR
  #undef PIN
  #undef MX3
  #undef GAPA
  #undef GAPB
  #undef EX
  #undef VRD
  #undef KRD
  #undef STEP
  #undef ENDW
  {auto rr=__builtin_amdgcn_permlane32_swap(__float_as_uint(l_reg),__float_as_uint(l_reg),false,false);l_reg=__uint_as_float(rr[0])+__uint_as_float(rr[1]);}
  if(hi==0)wsf[32+r32]=l_reg;asm volatile("s_waitcnt lgkmcnt(0)":::"memory");
  float rli[16];
  #pragma unroll
  for(int r=0;r<16;++r)rli[r]=__builtin_amdgcn_rcpf(wsf[32+crow(r,hi)]);
  bf16*Ow=O+(rowbase+q0+wid*QBLK)*DM+cvo;
  { bf16*stg=(bf16*)(shm+LDS_OST)+wid*2048;
    #pragma unroll
    for(int ph=0;ph<2;++ph){
    #pragma unroll
    for(int r=0;r<16;++r){const int orow=crow(r,hi);
      #pragma unroll
      for(int d0=0;d0<2;++d0)stg[orow*64+d0*32+r32]=__float2bfloat16(o[2*ph+d0][r]*rli[r]);}
    asm volatile("s_waitcnt lgkmcnt(0)":::"memory");
    #pragma unroll
    for(int i=0;i<4;++i){const int row=i*8+(lane>>3),ch=lane&7; const u32x4 v=*(const u32x4*)(stg+row*64+ch*8); ATTN_STORE16(Ow+(long)row*DM+ph*64+ch*8,v);}
    asm volatile("s_waitcnt lgkmcnt(0)":::"memory"); } }
  asm volatile("s_waitcnt lgkmcnt(0)\n\ts_barrier":::"memory");
  #undef DMA_K
  #undef DMA_V
  #undef CMASK
  #undef START
  #undef RESC
  #undef ROT
}
constexpr int ATTN_LDS_BYTES=LDS_BYTES;
#undef SBAR
#undef WAIT_BAR
}

namespace dil {
constexpr int D = 128;
constexpr float THR = 8.f;
constexpr bool WSKIP = true;
constexpr float SCALE = 0.08838834764831845f;
constexpr int NW = 8, QBLK = 32, KVBLK = 64, QB = NW * QBLK;
constexpr int SHM_V = KVBLK * D * 2, SHM_K = KVBLK * D * 2;
constexpr int LDS_OST = 2 * SHM_V + 2 * SHM_K + NW * 64 * 4;
constexpr int LDS_BYTES = LDS_OST + NW * 4096;
using bf16 = __hip_bfloat16;
typedef short bf16x8 __attribute__((ext_vector_type(8)));
typedef short s16x4 __attribute__((ext_vector_type(4)));
typedef float f32x16 __attribute__((ext_vector_type(16)));
typedef float f32x4 __attribute__((ext_vector_type(4)));
typedef unsigned u32x4 __attribute__((ext_vector_type(4)));
template <class A, class Bt> struct same_t { static constexpr bool v = false; };
template <class A> struct same_t<A, A> { static constexpr bool v = true; };

#define KSWZ(row, colB) ((row) * 256 + ((colB) ^ (((row) & 7) << 4)))
#define SBAR() __builtin_amdgcn_sched_barrier(0)
__device__ __forceinline__ int v_st(int k, int c) { const int kk = (k & ~0xC) | ((k & 4) << 1) | ((k & 8) >> 1); return ((kk >> 3) * 4 + (c >> 5)) * 512 + ((kk & 7) * 32 + (c & 31)) * 2; }
__device__ __forceinline__ int v_rd_base(int lane) { return ((lane & 3) << 3) | (((lane >> 2) & 3) << 6) | (((lane >> 4) & 1) << 5) | (((lane >> 5) & 1) << 8); }
constexpr int v_rd_off(int d0, int ks, int half) { return d0 * 512 + ks * 4096 + half * 2048; }
__device__ __forceinline__ int crow(int r, int hi) { return (r & 3) + 8 * (r >> 2) + 4 * hi; }
__device__ __forceinline__ unsigned cvtpk(float lo, float hi) {
    unsigned r; asm volatile("v_cvt_pk_bf16_f32 %0, %1, %2" : "=v"(r) : "v"(lo), "v"(hi)); return r;
}
__device__ __forceinline__ bf16x8 pack8(f32x4 a, f32x4 b) {
    u32x4 w = {cvtpk(a[0], a[1]), cvtpk(a[2], a[3]), cvtpk(b[0], b[1]), cvtpk(b[2], b[3])};
    return *reinterpret_cast<bf16x8*>(&w);
}
template <class T> __device__ __forceinline__ bf16x8 load8(const T* p) {
    if constexpr (same_t<T, float>::v) { return pack8(*(const f32x4*)p, *(const f32x4*)(p + 4)); }
    else { return *reinterpret_cast<const bf16x8*>(p); }
}
__device__ __forceinline__ void mask_tile(f32x16& p0, f32x16& p1, int dq, unsigned W) {
    const float NEG = -__builtin_inff();
#pragma unroll
    for (int r = 0; r < 16; ++r) {
        const int c = (r & 3) + 8 * (r >> 2);
        if ((unsigned)(dq - c) >= W) p0[r] = NEG;
        if ((unsigned)(dq - c - 32) >= W) p1[r] = NEG;
    }
}
__device__ __forceinline__ void partialSM(f32x16& p0, f32x16& p1, float& m_reg, float& mn, float& alpha) {
    float pmax = p0[0]; for (int r = 1; r < 16; ++r) pmax = fmaxf(pmax, p0[r]); for (int r = 0; r < 16; ++r) pmax = fmaxf(pmax, p1[r]);
    { auto rr = __builtin_amdgcn_permlane32_swap(__float_as_uint(pmax), __float_as_uint(pmax), false, false);
      pmax = fmaxf(__uint_as_float(rr[0]), __uint_as_float(rr[1])); }
    constexpr float C2 = 1.4426950408889634f * SCALE;
    if (__builtin_expect(__all((pmax - m_reg) * SCALE <= THR), 1)) { mn = m_reg; alpha = 1.f; }
    else { mn = fmaxf(m_reg, pmax); alpha = __builtin_amdgcn_exp2f((m_reg - mn) * C2); m_reg = mn; }
    const float mnL = -mn * C2;
    for (int r = 0; r < 16; ++r) p0[r] = fmaf(p0[r], C2, mnL); for (int r = 0; r < 16; ++r) p1[r] = fmaf(p1[r], C2, mnL);
    for (int r = 0; r < 16; ++r) p0[r] = __builtin_amdgcn_exp2f(p0[r]);
}
__device__ __forceinline__ void finishSM(f32x16& p0, f32x16& p1, float alpha, float& l_reg, bf16x8& pa0, bf16x8& pa1, bf16x8& pa2, bf16x8& pa3) {
    for (int r = 0; r < 16; ++r) p1[r] = __builtin_amdgcn_exp2f(p1[r]);
    float ps = 0; for (int r = 0; r < 16; ++r) ps += p0[r]; for (int r = 0; r < 16; ++r) ps += p1[r];
    { auto rr = __builtin_amdgcn_permlane32_swap(__float_as_uint(ps), __float_as_uint(ps), false, false);
      ps = __uint_as_float(rr[0]) + __uint_as_float(rr[1]); }
    l_reg = l_reg * alpha + ps;
#define PK4(P, B_, OUT) do { unsigned a0 = cvtpk(P[B_+0], P[B_+1]), a1 = cvtpk(P[B_+2], P[B_+3]);                          \
        unsigned b0 = cvtpk(P[B_+4], P[B_+5]), b1 = cvtpk(P[B_+6], P[B_+7]);                                             \
        auto r0 = __builtin_amdgcn_permlane32_swap(a0, b0, false, false); auto r1 = __builtin_amdgcn_permlane32_swap(a1, b1, false, false); \
        u32x4 w = {r0[0], r1[0], r0[1], r1[1]}; OUT = *reinterpret_cast<bf16x8*>(&w); } while (0)
    PK4(p0, 0, pa0); PK4(p0, 8, pa1); PK4(p1, 0, pa2); PK4(p1, 8, pa3);
#undef PK4
}
template <int KB, bool SK>
__device__ __forceinline__ void qkt(f32x16& p0, f32x16& p1, const char* K_lds, int r32, int hi, const bf16x8* qr, bool act) {
    if (SK && !act) { const float NEG = -__builtin_inff();
#pragma unroll
        for (int r = 0; r < 16; ++r) { p0[r] = NEG; p1[r] = NEG; } return; }
    p0 = f32x16{}; p1 = f32x16{};
    const char* kb[4];
#pragma unroll
    for (int dd = 0; dd < 4; ++dd) kb[dd] = K_lds + KB * SHM_K + KSWZ(r32, (dd * 16 + hi * 8) * 2);
#pragma unroll
    for (int d0 = 0; d0 < 8; ++d0) { const char* a = kb[d0 & 3] + (d0 >> 2) * 128;
        bf16x8 b0 = *reinterpret_cast<const bf16x8*>(a);
        bf16x8 b1 = *reinterpret_cast<const bf16x8*>(a + 32 * 256);
        p0 = __builtin_amdgcn_mfma_f32_32x32x16_bf16(b0, qr[d0], p0, 0, 0, 0);
        p1 = __builtin_amdgcn_mfma_f32_32x32x16_bf16(b1, qr[d0], p1, 0, 0, 0); }
}
template <int VB, bool SK>
__device__ __forceinline__ void pv_tile(f32x16* o, int vb0, bf16x8 pa0, bf16x8 pa1, bf16x8 pa2, bf16x8 pa3, bool act) {
    if (SK && !act) return;
#define TRRD(dst, off) asm volatile("ds_read_b64_tr_b16 %0, %1 offset:%2" : "=&v"(dst) : "v"(vb0), "i"(off) : "memory")
#define PV_D0(d0) do { s16x4 l0, l1, l2, l3, h0, h1, h2, h3; constexpr int b_ = VB * SHM_V + v_rd_off(d0, 0, 0);     \
        TRRD(l0, b_); TRRD(h0, b_ + 2048); TRRD(l1, b_ + 4096); TRRD(h1, b_ + 6144); TRRD(l2, b_ + 8192); TRRD(h2, b_ + 10240); TRRD(l3, b_ + 12288); TRRD(h3, b_ + 14336); \
        asm volatile("s_waitcnt lgkmcnt(0)" ::: "memory"); SBAR();                 \
        o[d0] = __builtin_amdgcn_mfma_f32_32x32x16_bf16(pa0, (bf16x8){l0[0], l0[1], l0[2], l0[3], h0[0], h0[1], h0[2], h0[3]}, o[d0], 0, 0, 0);   \
        o[d0] = __builtin_amdgcn_mfma_f32_32x32x16_bf16(pa1, (bf16x8){l1[0], l1[1], l1[2], l1[3], h1[0], h1[1], h1[2], h1[3]}, o[d0], 0, 0, 0);   \
        o[d0] = __builtin_amdgcn_mfma_f32_32x32x16_bf16(pa2, (bf16x8){l2[0], l2[1], l2[2], l2[3], h2[0], h2[1], h2[2], h2[3]}, o[d0], 0, 0, 0);   \
        o[d0] = __builtin_amdgcn_mfma_f32_32x32x16_bf16(pa3, (bf16x8){l3[0], l3[1], l3[2], l3[3], h3[0], h3[1], h3[2], h3[3]}, o[d0], 0, 0, 0); } while (0)
    PV_D0(0); PV_D0(1); PV_D0(2); PV_D0(3);
#undef PV_D0
#undef TRRD
}

template <class TIn, class TOut> struct BlockRef { const TIn* Q; const TIn* K; const TIn* V; TOut* O; float* LSE; int P0; int rs; int lrs; int skv; };
template <class TIn> struct Seam {
    bf16x8 qr[8];
    bf16x8 st_v0, st_v1, st_k0, st_k1; f32x4 sf0, sf1, sf2, sf3;
    f32x4 tq[16];
};
__device__ __forceinline__ int swa_jlo(int P0, int W) { const int lowk = P0 - 64; (void)W; return lowk > 0 ? lowk / KVBLK : 0; }
#define ROW(p, k0, rr) ((p) + (size_t)((k0) + (rr)) * RS_ + sc)
#define VMW() asm volatile("s_waitcnt vmcnt(0)" ::: "memory")
#define VMWN(n) asm volatile("s_waitcnt vmcnt(%0)" :: "i"(n) : "memory")
#define SLOAD_H(Kp, Vp, k0) do { S.st_v0 = load8<TIn>(ROW(Vp, k0, sr)); S.st_v1 = load8<TIn>(ROW(Vp, k0, 32 + sr));              \
                         S.st_k0 = load8<TIn>(ROW(Kp, k0, sr)); S.st_k1 = load8<TIn>(ROW(Kp, k0, 32 + sr)); } while (0)
#define SWRITE_HK(bf) do { *(bf16x8*)(K_lds + (bf) * SHM_K + kws) = S.st_k0; *(bf16x8*)(K_lds + (bf) * SHM_K + kws + 32 * 256) = S.st_k1; } while (0)
#define SWRITE_HV(bf) do { *(bf16x8*)(V_lds + (bf) * SHM_V + vst0) = S.st_v0; *(bf16x8*)(V_lds + (bf) * SHM_V + vst1) = S.st_v1; } while (0)
#define SWRITE_H(bf) do { SWRITE_HV(bf); SWRITE_HK(bf); } while (0)
#define SLOAD_F(p, k0) do { S.sf0 = *(const f32x4*)ROW(p, k0, sr); S.sf1 = *(const f32x4*)(ROW(p, k0, sr) + 4);                \
                            S.sf2 = *(const f32x4*)ROW(p, k0, 32 + sr); S.sf3 = *(const f32x4*)(ROW(p, k0, 32 + sr) + 4); } while (0)
#define SWRITE_KF(bf) do { *(bf16x8*)(K_lds + (bf) * SHM_K + kws) = pack8(S.sf0, S.sf1); *(bf16x8*)(K_lds + (bf) * SHM_K + kws + 32 * 256) = pack8(S.sf2, S.sf3); } while (0)
#define SWRITE_VF(bf) do { *(bf16x8*)(V_lds + (bf) * SHM_V + vst0) = pack8(S.sf0, S.sf1); *(bf16x8*)(V_lds + (bf) * SHM_V + vst1) = pack8(S.sf2, S.sf3); } while (0)
template <class TIn, class TOut>
__device__ __forceinline__ void causal_swa_prime(const BlockRef<TIn, TOut>& cur, int W, char* lds, Seam<TIn>& S) {
    constexpr bool F32 = same_t<TIn, float>::v;
    const int tid = tid_fresh(), wid = __builtin_amdgcn_readfirstlane(tid >> 6), lane = tid & 63, r32 = lane & 31, hi = lane >> 5;
    const int sr = tid >> 4, sc = (tid & 15) * 8, kws = KSWZ(sr, sc * 2); char* K_lds = lds + 2 * SHM_V;
    const int kb0 = swa_jlo(cur.P0, W) * KVBLK; const size_t RS_ = (size_t)cur.rs;
    for (int d0 = 0; d0 < 8; ++d0) S.qr[d0] = load8<TIn>(cur.Q + (size_t)(wid * QBLK + r32) * RS_ + d0 * 16 + hi * 8);
    if constexpr (F32) { SLOAD_F((const float*)cur.K, kb0); VMW(); SWRITE_KF(0); SBAR(); SLOAD_F((const float*)cur.V, kb0); }
    else { SLOAD_H(cur.K, cur.V, kb0); VMW(); SWRITE_HK(0); }
    __syncthreads();
}
template <class TIn, class TOut>
__device__ __forceinline__ void causal_swa_block(const BlockRef<TIn, TOut>& cur, const BlockRef<TIn, TOut>& nxt, int W, char* lds, Seam<TIn>& S) {
    constexpr bool F32 = same_t<TIn, float>::v;
    const int tid = tid_fresh(), wid = __builtin_amdgcn_readfirstlane(tid >> 6), lane = tid & 63, r32 = lane & 31, hi = lane >> 5;
    const int j_lo = swa_jlo(cur.P0, W);
    int j_hi = (cur.P0 + QB - 1 + 64) / KVBLK + 1; if (j_hi > cur.skv / KVBLK) j_hi = cur.skv / KVBLK;
    const int NT = j_hi - j_lo;
    const int kbn = swa_jlo(nxt.P0, W) * KVBLK;
    const int qlo = cur.P0 + wid * QBLK, qm = qlo + r32 - 4 * hi;
    char* V_lds = lds; char* K_lds = lds + 2 * SHM_V;
    float* ws = (float*)(lds + 2 * SHM_V + 2 * SHM_K) + wid * 64; float* li_l = ws, * al_l = ws + 32;
    float m_reg = -1e30f, l_reg = 0; f32x16 o[4] = {};
    const int sr = tid >> 4, sc = (tid & 15) * 8, vst0 = v_st(sr, sc), vst1 = v_st(32 + sr, sc), kws = KSWZ(sr, sc * 2);
    const int vb0 = (int)(uintptr_t)V_lds + v_rd_base(lane);
    const TIn* Kh = cur.K; const TIn* Vh = cur.V; size_t RS_ = (size_t)cur.rs;
#define RESC(a) do { if (__any((a) < 1.f)) { if (hi == 0) al_l[r32] = (a); asm volatile("s_waitcnt lgkmcnt(0)" ::: "memory");              \
                     for (int d_ = 0; d_ < 4; ++d_) for (int r = 0; r < 16; ++r) o[d_][r] *= al_l[crow(r, hi)]; } } while (0)
#define KBASE(t) ((j_lo + (t)) * KVBLK)
#define ACT(t) (KBASE(t) <= qlo + QBLK - 1 + 64 && KBASE(t) + KVBLK - 1 >= qlo - 64)
#define MASKT(P0_, P1_, t) do { const int kb_ = KBASE(t); if (!SK || ACT(t)) mask_tile(P0_, P1_, qm - kb_ + 64, 129u); } while (0)
    constexpr int NQL = F32 ? 16 : 8;
    constexpr bool SK = WSKIP && !F32;
#define SEAM_K0() do { VMWN(NQL); if constexpr (F32) { SWRITE_KF(0); SBAR(); SLOAD_F((const float*)nxt.V, kbn); } else { SWRITE_HK(0); } SBAR(); } while (0)
    f32x16 pA0, pA1, pB0, pB1; float mnA, mnB, alA, alB; bf16x8 pa0, pa1, pa2, pa3;
    if constexpr (F32) { VMW(); SWRITE_VF(0); SBAR(); } else { SWRITE_HV(0); SBAR(); }
    if (NT > 1) { if constexpr (F32) SLOAD_F((const float*)Kh, KBASE(1)); else SLOAD_H(Kh, Vh, KBASE(1)); }
    SBAR(); qkt<0, SK>(pA0, pA1, K_lds, r32, hi, S.qr, ACT(0));
    if constexpr (F32) { if (NT > 1) { VMW(); SWRITE_KF(1); SBAR(); SLOAD_F((const float*)Vh, KBASE(1)); } }
    MASKT(pA0, pA1, 0); partialSM(pA0, pA1, m_reg, mnA, alA);
    if (NT > 1) { VMW(); if constexpr (F32) { SWRITE_VF(1); SBAR(); if (NT > 2) SLOAD_F((const float*)Kh, KBASE(2)); } else SWRITE_H(1); }
    __syncthreads();
#define HALF_STEP(PX0, PX1, mnX, alX, PY0, PY1, alY, t, KB, VB, SB) do {                                                      \
        SBAR(); qkt<KB, SK>(PX0, PX1, K_lds, r32, hi, S.qr, ACT(t));                                             \
        finishSM(PY0, PY1, alY, l_reg, pa0, pa1, pa2, pa3); SBAR();                                                           \
        if ((t) + 1 < NT) { if constexpr (F32) { VMW(); SWRITE_KF(SB); SBAR(); SLOAD_F((const float*)Vh, KBASE((t) + 1)); }  \
                            else { SLOAD_H(Kh, Vh, KBASE((t) + 1)); } SBAR(); }                                               \
        pv_tile<VB, SK>(o, vb0, pa0, pa1, pa2, pa3, ACT((t) - 1)); MASKT(PX0, PX1, (t)); partialSM(PX0, PX1, m_reg, mnX, alX);                                        \
        __syncthreads();                                                                                                      \
        if ((t) + 1 < NT) { VMW(); if constexpr (F32) { SWRITE_VF(SB); SBAR(); if ((t) + 2 < NT) SLOAD_F((const float*)Kh, KBASE((t) + 2)); } \
                            else { SWRITE_H(SB); } }                                                                          \
        RESC(alX); __syncthreads(); } while (0)
    for (int t = 1; t + 1 < NT; t += 2) {
        HALF_STEP(pB0, pB1, mnB, alB, pA0, pA1, alA, t, 1, 0, 0);
        HALF_STEP(pA0, pA1, mnA, alA, pB0, pB1, alB, t + 1, 0, 1, 1);
    }
    const bool even = (NT & 1) == 0;
    if (even) { SBAR(); qkt<1, SK>(pB0, pB1, K_lds, r32, hi, S.qr, ACT(NT - 1)); SBAR(); }
#define QROW(e) (nxt.Q + (size_t)(wid * QBLK + r32) * (size_t)nxt.rs + ((e) >> 1) * 16 + hi * 8 + ((e) & 1) * 4)
    RS_ = (size_t)nxt.rs;
    if constexpr (F32) { SLOAD_F((const float*)nxt.K, kbn); SBAR();
#pragma unroll
        for (int e = 0; e < 8; ++e) S.tq[e] = *(const f32x4*)QROW(e); }
    else { SLOAD_H(nxt.K, nxt.V, kbn); SBAR();
#pragma unroll
        for (int d0 = 0; d0 < 8; ++d0) S.qr[d0] = load8<TIn>(nxt.Q + (size_t)(wid * QBLK + r32) * (size_t)nxt.rs + d0 * 16 + hi * 8); }
    SBAR();
    finishSM(pA0, pA1, alA, l_reg, pa0, pa1, pa2, pa3); SBAR();
    if constexpr (F32) {
#pragma unroll
        for (int e = 8; e < 16; ++e) S.tq[e] = *(const f32x4*)QROW(e); SBAR(); }
#undef QROW
    pv_tile<0, SK>(o, vb0, pa0, pa1, pa2, pa3, ACT(even ? NT - 2 : NT - 1));
    if (even) { MASKT(pB0, pB1, NT - 1); partialSM(pB0, pB1, m_reg, mnB, alB); __syncthreads(); RESC(alB);
        finishSM(pB0, pB1, alB, l_reg, pa0, pa1, pa2, pa3); SBAR(); pv_tile<1, SK>(o, vb0, pa0, pa1, pa2, pa3, ACT(NT - 1)); }
    SBAR(); SEAM_K0();
    if (hi == 0) { li_l[r32] = l_reg; cur.LSE[(size_t)(wid * QBLK + r32) * (size_t)cur.lrs] = m_reg * SCALE + __builtin_amdgcn_logf(l_reg) * 0.6931471805599453f; }
    asm volatile("s_waitcnt lgkmcnt(0)" ::: "memory");
    float rli[16];
#pragma unroll
    for (int r = 0; r < 16; ++r) rli[r] = __builtin_amdgcn_rcpf(li_l[crow(r, hi)]);
    const size_t ORS = (size_t)cur.rs; TOut* Ow = cur.O + (size_t)(wid * QBLK) * ORS;
    if constexpr (same_t<TOut, float>::v) {
#pragma unroll
    for (int r = 0; r < 16; ++r) { const int orow = crow(r, hi);
#pragma unroll
        for (int d0 = 0; d0 < 4; ++d0) Ow[(size_t)orow * ORS + d0 * 32 + r32] = o[d0][r] * rli[r]; }
    } else {
    bf16* stg = (bf16*)(lds + LDS_OST) + wid * 2048;
#pragma unroll
    for (int ph = 0; ph < 2; ++ph) {
#pragma unroll
        for (int r = 0; r < 16; ++r) { const int orow = crow(r, hi);
#pragma unroll
            for (int d0 = 0; d0 < 2; ++d0) stg[orow * 64 + d0 * 32 + r32] = __float2bfloat16(o[2 * ph + d0][r] * rli[r]); }
        asm volatile("s_waitcnt lgkmcnt(0)" ::: "memory");
#pragma unroll
        for (int i = 0; i < 4; ++i) { const int row = i * 8 + (lane >> 3), ch = lane & 7; const u32x4 v = *(const u32x4*)(stg + row * 64 + ch * 8); *(u32x4*)(Ow + (size_t)row * ORS + ph * 64 + ch * 8) = v; }
        asm volatile("s_waitcnt lgkmcnt(0)" ::: "memory"); }
    }
    if constexpr (F32) {
#pragma unroll
        for (int d0 = 0; d0 < 8; ++d0) S.qr[d0] = pack8(S.tq[2 * d0], S.tq[2 * d0 + 1]); }
    __syncthreads();
#undef RESC
#undef KBASE
#undef ACT
#undef MASKT
#undef SEAM_K0
#undef HALF_STEP
}
#undef ROW
#undef VMW
#undef VMWN
#undef SLOAD_H
#undef SWRITE_HK
#undef SWRITE_HV
#undef SWRITE_H
#undef SLOAD_F
#undef SWRITE_KF
#undef SWRITE_VF
}

constexpr int NWAVES = 8;
constexpr int M = 16384, SEQ = 4096, DMODEL = 2048, INW = 6144;
constexpr int NEXP = 16384;
constexpr float LN_EPS = 1e-5f;
constexpr float ALPHA = 1.189207115002721f;
constexpr float LAM_INIT = 0.2f;
constexpr int N_LAUNCHES = MK_N_LAUNCHES, PER_PHASE = 12;

constexpr size_t MiB = 1u << 20;
constexpr size_t WS_CTL = 0, CTL_ZERO_BYTES = 64 * 1024;
constexpr size_t WS_KEYS = 1 * MiB;
constexpr size_t WS_ROPEA = 1 * MiB + 512 * 1024;
constexpr size_t WS_ROPED = 2 * MiB;
constexpr size_t WS_LSE = 2 * MiB + 256 * 1024;
constexpr size_t WS_WOUT = 5 * MiB, WS_WQ = 13 * MiB, WS_WIN = 21 * MiB;
constexpr size_t WS_XN = 46 * MiB;
constexpr size_t WS_QA = 110 * MiB, WS_KA = 158 * MiB, WS_VA = 206 * MiB;
constexpr size_t WS_QD = 254 * MiB, WS_KD = 270 * MiB, WS_VD = 286 * MiB;
constexpr size_t WS_OC = 302 * MiB;
constexpr size_t WS_OD = 446 * MiB;
constexpr size_t WS_MIXED = 110 * MiB;
constexpr size_t WS_PRE = 302 * MiB;
constexpr size_t WS_H1 = 174 * MiB;
constexpr size_t WS_QP = 238 * MiB;
constexpr size_t WS_U8 = 46 * MiB, WS_V8 = 78 * MiB;
constexpr size_t WS_USC = 4608 * 1024, WS_VSC = WS_USC + 65536;
constexpr size_t WS_SX = WS_VSC + 65536;
constexpr size_t WS_SA0 = WS_SX + 65536, WS_SA1 = WS_SA0 + 65536, WS_SWI = WS_SA1 + 65536, WS_SWO = WS_SWI + 32768;
constexpr size_t WS_XN8 = 302 * MiB;
constexpr size_t WS_X8 = 110 * MiB;
constexpr size_t WS_IDX = 430 * MiB, WS_G = 438 * MiB;
constexpr size_t WS_ZP = 238 * MiB;
constexpr size_t WS_A = 366 * MiB;
constexpr size_t WS_Y = 238 * MiB;
constexpr size_t WS_END = 480 * MiB;
constexpr int CW_BAR = 4096;
constexpr size_t WS_CM = 32 * 1024;

constexpr int RING_OFF = 0, RING_BYTES = 131072;
constexpr int LDSCTL_OFF = RING_BYTES, MISC_OFF = LDSCTL_OFF + 320;
constexpr int LDS_BYTES = 147456;
static_assert(MISC_OFF + 128 <= LDS_BYTES && attn_body::ATTN_LDS_BYTES <= RING_BYTES && dil::LDS_BYTES <= RING_BYTES, "LDS map");

#define GAS __attribute__((address_space(1)))
#define LAS __attribute__((address_space(3)))
typedef unsigned short bf16;
typedef unsigned v4u __attribute__((ext_vector_type(4)));
typedef float f32x4 __attribute__((ext_vector_type(4)));
typedef float f32x2 __attribute__((ext_vector_type(2)));
typedef short bf16x8 __attribute__((ext_vector_type(8)));
typedef GAS unsigned gu32;
typedef GAS unsigned long long gu64;
#define RLX_AGENT __ATOMIC_RELAXED, __HIP_MEMORY_SCOPE_AGENT
#define LDS_WAIT() asm volatile("s_waitcnt lgkmcnt(0)" ::: "memory")
#define VM_WAIT() asm volatile("s_waitcnt vmcnt(0)" ::: "memory")
__device__ __forceinline__ unsigned long long rt() { return __builtin_amdgcn_s_memrealtime(); }
__device__ __forceinline__ unsigned f2bf(float f) { unsigned u = __builtin_bit_cast(unsigned, f); return (u + 0x7fffu + ((u >> 16) & 1u)) >> 16; }
__device__ __forceinline__ unsigned pk2(float lo, float hi) { return f2bf(lo) | (f2bf(hi) << 16); }

#define XB_TMO      128
#define XB_XCNT(j)  (256  + 64 * (j))
#define XB_XSUB(j)  (1280 + 64 * (j))
#define XB_XGEN(j)  (2304 + 64 * (j))
#define XB_TOP      3328
#define XB_TOPGEN   3392
#define XCD_BAR_WORDS 3456
#define XB_SPIN_CAP (1u << 18)

__device__ __forceinline__ unsigned xb_ld(unsigned* p)              { return __hip_atomic_load(p, __ATOMIC_RELAXED, __HIP_MEMORY_SCOPE_AGENT); }
__device__ __forceinline__ unsigned xb_add(unsigned* p, unsigned v) { return __hip_atomic_fetch_add(p, v, __ATOMIC_RELAXED, __HIP_MEMORY_SCOPE_AGENT); }
__device__ __forceinline__ unsigned xb_xcc_id() { return (unsigned)__builtin_amdgcn_s_getreg((3 << 11) | 20) & 0xFu; }
#define XB_SPIN(cond, bar) do { unsigned _sp = 0; while (cond) { __builtin_amdgcn_s_sleep(1); \
    if ((++_sp & 255u) == 0u) { if (xb_ld(&(bar)[XB_TMO])) break; if (_sp > XB_SPIN_CAP) { atomicAdd(&(bar)[XB_TMO], 1u); break; } } } } while (0)

struct XcdBarrier {
    unsigned* bar; unsigned x;
    volatile LAS unsigned* st;
};

__device__ __forceinline__ XcdBarrier xcd_barrier_post(unsigned* bar, volatile LAS unsigned* st) {
    XcdBarrier b; b.bar = bar; b.x = xb_xcc_id(); b.st = st;
    if (threadIdx.x == 0) (void)xb_add(&bar[XB_XCNT(b.x)], 1u);
    return b;
}
__device__ __forceinline__ void xcd_barrier_complete(unsigned* bar, unsigned x, unsigned& nloc, unsigned& nx) {
    const unsigned G = gridDim.x * gridDim.y * gridDim.z;
    unsigned sum, cnt, mine, sp = 0u;
    for (;;) {
        sum = 0u; cnt = 0u; mine = 0u;
#pragma unroll
        for (unsigned j = 0; j < 16; ++j) { const unsigned c = xb_ld(&bar[XB_XCNT(j)]); sum += c; cnt += (c > 0u) ? 1u : 0u; mine = (j == x) ? c : mine; }
        if (sum == G) break;
        __builtin_amdgcn_s_sleep(1);
        if ((++sp & 255u) == 0u) { if (xb_ld(&bar[XB_TMO])) break; if (sp > XB_SPIN_CAP) { atomicAdd(&bar[XB_TMO], 1u); break; } }
    }
    nloc = mine > 0u ? mine : 1u; nx = cnt > 0u ? cnt : 1u;
}

__device__ __forceinline__ void xcd_barrier(const XcdBarrier& b) {
    asm volatile("s_waitcnt vmcnt(0)" ::: "memory");
    __syncthreads();
    if (threadIdx.x == 0) {
        unsigned* bar = b.bar;
        __builtin_amdgcn_s_waitcnt(0);
        unsigned nloc = b.st[0], nx = b.st[1];
        if (nloc == 0u) { xcd_barrier_complete(bar, b.x, nloc, nx); b.st[0] = nloc; b.st[1] = nx; }
        const unsigned old = xb_add(&bar[XB_XSUB(b.x)], 1u);
        const unsigned gen = old / nloc;
        if (old + 1u == (gen + 1u) * nloc) {
            __builtin_amdgcn_fence(__ATOMIC_RELEASE, "agent");
            asm volatile("s_waitcnt vmcnt(0)" ::: "memory");
            const unsigned og = xb_add(&bar[XB_TOP], 1u);
            const unsigned tg = og / nx;
            if (og + 1u == (tg + 1u) * nx) xb_add(&bar[XB_TOPGEN], 1u);
            else XB_SPIN(xb_ld(&bar[XB_TOPGEN]) == tg, bar);
            __builtin_amdgcn_fence(__ATOMIC_ACQUIRE, "agent");
            xb_add(&bar[XB_XGEN(b.x)], 1u);
            asm volatile("s_waitcnt vmcnt(0)" ::: "memory");
        } else {
            XB_SPIN(xb_ld(&bar[XB_XGEN(b.x)]) == gen, bar);
            __builtin_amdgcn_fence(__ATOMIC_ACQUIRE, "agent");
            asm volatile("s_waitcnt vmcnt(0)" ::: "memory");
        }
    }
    __syncthreads();
}

struct Frame {
    LAS unsigned char* lds;
    volatile LAS unsigned* MISC;
    gu32* ctl;
    int tid, lane, wave;
    int vcu, G;
};
__device__ __forceinline__ float wave_sum(float v) {
#pragma unroll
    for (int o = 1; o < 64; o <<= 1) v += __shfl_xor(v, o);
    return v;
}
__device__ __forceinline__ int lane_id_fresh() { int l; asm volatile("v_mbcnt_lo_u32_b32 %0, -1, 0\n\tv_mbcnt_hi_u32_b32 %0, -1, %0" : "=v"(l)); return l; }
template <int CTRL> __device__ __forceinline__ float dpp_f(float v) { return __int_as_float(__builtin_amdgcn_update_dpp(0, __float_as_int(v), CTRL, 0xf, 0xf, true)); }
__device__ __forceinline__ float xchg32(float a, float b) { auto r = __builtin_amdgcn_permlane32_swap(__float_as_uint(a), __float_as_uint(b), false, false); return __uint_as_float(r[0]) + __uint_as_float(r[1]); }
__device__ __forceinline__ float xchg16(float a, float b) { auto r = __builtin_amdgcn_permlane16_swap(__float_as_uint(a), __float_as_uint(b), false, false); return __uint_as_float(r[0]) + __uint_as_float(r[1]); }
__device__ __forceinline__ float bflo(unsigned w) { return __uint_as_float(w << 16); }
__device__ __forceinline__ float bfhi(unsigned w) { return __uint_as_float(w & 0xffff0000u); }

__device__ __forceinline__ void p0_transpose_item(const float* W, int K, int N, bf16* WT, LAS float* scr, int item, int lane) {
    const int nblk = N / 32, kb = item / nblk, nb = item % nblk, k0 = 64 * kb, n0 = 32 * nb;
#pragma unroll 8
    for (int i = 0; i < 32; ++i) { const int kk = 2 * i + (lane >> 5); scr[kk * 33 + (lane & 31)] = __builtin_nontemporal_load(W + (size_t)(k0 + kk) * N + n0 + (lane & 31)); }
    LDS_WAIT(); asm volatile("" ::: "memory");
    const int c = lane & 7;
#pragma unroll
    for (int j = 0; j < 4; ++j) { const int n = (lane >> 3) + 8 * j; const LAS float* s = scr + (8 * c) * 33 + n;
        v4u o; o.x = pk2(s[0 * 33], s[1 * 33]); o.y = pk2(s[2 * 33], s[3 * 33]); o.z = pk2(s[4 * 33], s[5 * 33]); o.w = pk2(s[6 * 33], s[7 * 33]);
        *(GAS v4u*)(WT + (size_t)(n0 + n) * K + k0 + 8 * c) = o; }
    LDS_WAIT(); asm volatile("" ::: "memory");
}
__device__ __forceinline__ void p0_quant_item(const float* W, int N, int n0, unsigned char* WT8, float* SW, LAS unsigned char* ldsb, int tid) {
    LAS float* red = (LAS float*)ldsb;
    const int n = tid & 31;
    {
        const int c = tid & 7, r0 = tid >> 3;
        const GAS f32x4* col = (const GAS f32x4*)(W + (size_t)r0 * N + n0 + 4 * c);
        f32x4 m4 = {0.f, 0.f, 0.f, 0.f};
#pragma unroll 16
        for (int i = 0; i < 32; ++i) { const f32x4 v = col[(size_t)i * 16 * N];
            m4.x = fmaxf(m4.x, fabsf(v.x)); m4.y = fmaxf(m4.y, fabsf(v.y)); m4.z = fmaxf(m4.z, fabsf(v.z)); m4.w = fmaxf(m4.w, fabsf(v.w)); }
#pragma unroll
        for (int o = 8; o < 64; o <<= 1) { m4.x = fmaxf(m4.x, __shfl_xor(m4.x, o)); m4.y = fmaxf(m4.y, __shfl_xor(m4.y, o)); m4.z = fmaxf(m4.z, __shfl_xor(m4.z, o)); m4.w = fmaxf(m4.w, __shfl_xor(m4.w, o)); }
        if ((tid & 63) < 8) *(LAS f32x4*)(red + (tid >> 6) * 32 + 4 * c) = m4;
    }
    __syncthreads();
    if (tid < 32) { float m = 0.f;
#pragma unroll
        for (int r = 0; r < 8; ++r) m = fmaxf(m, red[r * 32 + tid]);
        red[512 + tid] = m > 0.f ? 127.f / m : 1.f; SW[n0 + tid] = m > 0.f ? m * (1.f / 127.f) : 1.f; }
    __syncthreads();
    const int lane = tid & 63, wave = tid >> 6, kh = lane >> 5;
    const float qs = red[512 + n];
    LAS unsigned char* tile = ldsb + 4096 + wave * 4608;
    for (int kt = wave; kt < 16; kt += 8) {
        const int k0 = kt * 128;
#pragma unroll 8
        for (int i = 0; i < 16; ++i) {
            const float* p = W + (size_t)(k0 + 8 * i + 4 * kh) * N + n0 + n;
            const int a0 = (int)rintf(p[0] * qs), a1 = (int)rintf(p[(size_t)N] * qs), a2 = (int)rintf(p[(size_t)2 * N] * qs), a3 = (int)rintf(p[(size_t)3 * N] * qs);
            *(LAS unsigned*)(tile + n * 144 + 8 * i + 4 * kh) = (unsigned)(a0 & 255) | ((unsigned)(a1 & 255) << 8) | ((unsigned)(a2 & 255) << 16) | ((unsigned)(a3 & 255) << 24);
        }
        LDS_WAIT(); asm volatile("" ::: "memory");
#pragma unroll
        for (int j = 0; j < 4; ++j) { const int nr = (lane >> 3) + 8 * j, c = lane & 7;
            const v4u o = *(const LAS v4u*)(tile + nr * 144 + 16 * c);
            *(GAS v4u*)(WT8 + (size_t)(n0 + nr) * 2048 + k0 + 16 * c) = o; }
        LDS_WAIT(); asm volatile("" ::: "memory");
    }
    __syncthreads();
}
__device__ __forceinline__ void p0_colmax_item(const float* W, int N, int* CM, int item, int lane) {
    const int nblk = N / 32, kb = item / nblk, nb = item % nblk, k0 = 64 * kb, n0 = 32 * nb;
    float mx = 0.f;
#pragma unroll 16
    for (int i = 0; i < 32; ++i) { const int kk = 2 * i + (lane >> 5); mx = fmaxf(mx, fabsf(__builtin_nontemporal_load(W + (size_t)(k0 + kk) * N + n0 + (lane & 31)))); }
    mx = fmaxf(mx, __shfl_xor(mx, 32));
    if (lane < 32) atomicMax(CM + n0 + lane, __float_as_int(mx));
}
__device__ __forceinline__ void wq_quant_item(const float* W, const float* CM, unsigned char* WT8, LAS unsigned char* tile, int item, int lane) {
    const int kt = item >> 6, n0 = 32 * (item & 63), k0 = kt * 64, n = lane & 31, kh = lane >> 5;
    const float cm = CM[n0 + n], qs = cm > 0.f ? 127.f / cm : 1.f;
#pragma unroll
    for (int i = 0; i < 8; ++i) {
        const float* p = W + (size_t)(k0 + 8 * i + 4 * kh) * 2048 + n0 + n;
        const int a0 = (int)rintf(p[0] * qs), a1 = (int)rintf(p[2048] * qs), a2 = (int)rintf(p[2 * 2048] * qs), a3 = (int)rintf(p[3 * 2048] * qs);
        *(LAS unsigned*)(tile + n * 80 + 8 * i + 4 * kh) = (unsigned)(a0 & 255) | ((unsigned)(a1 & 255) << 8) | ((unsigned)(a2 & 255) << 16) | ((unsigned)(a3 & 255) << 24);
    }
    LDS_WAIT(); asm volatile("" ::: "memory");
#pragma unroll
    for (int j = 0; j < 2; ++j) { const int nr = (lane >> 2) + 16 * j, c = lane & 3;
        const v4u o = *(const LAS v4u*)(tile + nr * 80 + 16 * c);
        *(GAS v4u*)(WT8 + (size_t)(n0 + nr) * 2048 + k0 + 16 * c) = o; }
    LDS_WAIT(); asm volatile("" ::: "memory");
}
__device__ __forceinline__ void ln_row_load(int lane, const float* xrow, f32x4 (&v)[8]) {
    const GAS f32x4* xr = (const GAS f32x4*)xrow + lane;
#pragma unroll
    for (int j = 0; j < 8; ++j) v[j] = __builtin_nontemporal_load(xr + 64 * j);
}
__device__ __forceinline__ void ln_row_load_bf16(int lane, const bf16* xrow, f32x4 (&v)[8]) {
    const GAS unsigned long long* xr = (const GAS unsigned long long*)xrow + lane;
#pragma unroll
    for (int j = 0; j < 8; ++j) { const unsigned long long h = __builtin_nontemporal_load(xr + 64 * j); const unsigned hl = (unsigned)h, hh = (unsigned)(h >> 32);
        v[j] = (f32x4){__uint_as_float(hl << 16), __uint_as_float(hl & 0xffff0000u), __uint_as_float(hh << 16), __uint_as_float(hh & 0xffff0000u)}; }
}
__device__ __forceinline__ void ln_row_to_bf16(int lane, f32x4 (&v)[8], const float* g, const float* b, bf16* orow, unsigned char* o8row, float* sc) {
    float s = 0.f;
#pragma unroll
    for (int j = 0; j < 8; ++j) s += (v[j].x + v[j].y) + (v[j].z + v[j].w);
    const float mean = wave_sum(s) * (1.f / DMODEL); float s2 = 0.f;
#pragma unroll
    for (int j = 0; j < 8; ++j) { v[j] = v[j] - mean; s2 += (v[j].x * v[j].x + v[j].y * v[j].y) + (v[j].z * v[j].z + v[j].w * v[j].w); }
    const float rstd = 1.f / sqrtf(wave_sum(s2) * (1.f / DMODEL) + LN_EPS);
    GAS unsigned long long* o8 = (GAS unsigned long long*)orow + lane;
    const GAS f32x4* gr = (const GAS f32x4*)g + lane; const GAS f32x4* br = (const GAS f32x4*)b + lane;
    float mx = 0.f;
#pragma unroll
    for (int j = 0; j < 8; ++j) { const f32x4 gg = gr[64 * j], bb = br[64 * j]; v[j] = v[j] * rstd * gg + bb;
        o8[64 * j] = (unsigned long long)pk2(v[j].x, v[j].y) | ((unsigned long long)pk2(v[j].z, v[j].w) << 32);
        mx = fmaxf(mx, fmaxf(fmaxf(fabsf(v[j].x), fabsf(v[j].y)), fmaxf(fabsf(v[j].z), fabsf(v[j].w)))); }
#pragma unroll
    for (int o = 1; o < 64; o <<= 1) mx = fmaxf(mx, __shfl_xor(mx, o));
    const float qs = mx > 0.f ? 127.f / mx : 1.f;
    if (lane == 0) *sc = mx > 0.f ? mx * (1.f / 127.f) : 1.f;
    GAS unsigned* x8 = (GAS unsigned*)o8row + lane;
#pragma unroll
    for (int j = 0; j < 8; ++j) { const int a0 = (int)rintf(v[j].x * qs), a1 = (int)rintf(v[j].y * qs), a2 = (int)rintf(v[j].z * qs), a3 = (int)rintf(v[j].w * qs);
        x8[64 * j] = (unsigned)(a0 & 255) | ((unsigned)(a1 & 255) << 8) | ((unsigned)(a2 & 255) << 16) | ((unsigned)(a3 & 255) << 24); }
}
__device__ __forceinline__ void cvt_chunks(const float* src, bf16* dst, size_t nchunks, int gw, int NGW, int lane) {
    for (size_t c = gw; c < nchunks; c += NGW) {
        const GAS f32x4* s = (const GAS f32x4*)(src + c * 512) + 2 * lane; const f32x4 a = s[0], b = s[1];
        v4u o; o.x = pk2(a.x, a.y); o.y = pk2(a.z, a.w); o.z = pk2(b.x, b.y); o.w = pk2(b.z, b.w);
        *((GAS v4u*)(dst + c * 512) + lane) = o; }
}
__device__ __forceinline__ float gelu_erf(float v) {
    const float av = fabsf(v), d = av * 0.2316418882f + 1.0f, t = __builtin_amdgcn_rcpf(d);
    float q = t * 0.5307027145f + (-0.7265760135f); q = q * t + 0.7107068705f; q = q * t + (-0.142248368f); q = q * t + 0.127414796f; q = q * t;
    const float e = __builtin_amdgcn_exp2f((v * v) * (-0.72134752044f));
    const float m = v * (q * e);
    return v < 0.f ? m : v - m;
}


__device__ __forceinline__ dil::BlockRef<dil::bf16, dil::bf16> dil_ref(int id, const unsigned short* QA, const unsigned short* KA, const unsigned short* VA, unsigned short* OC, float* LSE) {
    const int bh = id / 48, rest = id - bh * 48, cfg = rest >> 4, sub = rest & 15;
    const int b = bh / 12, h = bh - b * 12;
    const int r = cfg == 0 ? 1 : (cfg == 1 ? 4 : 16);
    const int nblk = 16 / r;
    const int rho = sub / nblk, n = sub - rho * nblk;
    const int P0 = n * 256;
    dil::BlockRef<dil::bf16, dil::bf16> br;
    const size_t row0 = (size_t)b * 4096 + (size_t)P0 * r + rho;
    br.Q = (const dil::bf16*)QA + row0 * 1536 + h * 128;
    br.K = (const dil::bf16*)KA + ((size_t)b * 4096 + rho) * 1536 + h * 128;
    br.V = (const dil::bf16*)VA + ((size_t)b * 4096 + rho) * 1536 + h * 128;
    br.O = (dil::bf16*)OC + (size_t)cfg * 16384 * 1536 + row0 * 1536 + h * 128;
    br.LSE = LSE + (size_t)cfg * 16384 * 12 + row0 * 12 + h;
    br.P0 = P0; br.rs = r * 1536; br.lrs = r * 12; br.skv = 4096 / r;
    return br;
}

typedef __bf16 bf16x2v __attribute__((ext_vector_type(2)));
__device__ __forceinline__ float dot2_bf16(unsigned w, unsigned x, float acc) { return __builtin_amdgcn_fdot2_f32_bf16(__builtin_bit_cast(bf16x2v, w), __builtin_bit_cast(bf16x2v, x), acc, false); }

struct Args { const float* in[19]; float* out; unsigned char* ws; int ph_lo, ph_hi, li, pad; };

__device__ __forceinline__ int fkey(float f) { const int b = __float_as_int(f); return b ^ ((b >> 31) & 0x7fffffff); }
__device__ __forceinline__ float keyf(int k) { return __int_as_float(k ^ ((k >> 31) & 0x7fffffff)); }
#define CE_DESC(a_, b_) do { const int hi__ = max(a_, b_), lo__ = min(a_, b_); a_ = hi__; b_ = lo__; } while (0)
__device__ __forceinline__ void bitonic_sort16_desc(int (&a)[16]) {
#pragma unroll
    for (int k = 2; k <= 16; k <<= 1)
#pragma unroll
        for (int j = k >> 1; j > 0; j >>= 1)
#pragma unroll
            for (int i = 0; i < 16; ++i) { const int l = i ^ j; if (l > i) { if ((i & k) == 0) CE_DESC(a[i], a[l]); else CE_DESC(a[l], a[i]); } }
}
__device__ __forceinline__ void bitonic_merge16_desc(int (&a)[16]) {
#pragma unroll
    for (int j = 8; j > 0; j >>= 1)
#pragma unroll
        for (int i = 0; i < 16; ++i) { const int l = i ^ j; if (l > i) CE_DESC(a[i], a[l]); }
}
__device__ __forceinline__ void top16_merge(int (&L)[16], const int (&B)[16]) {
#pragma unroll
    for (int i = 0; i < 16; ++i) L[i] = max(L[i], B[15 - i]);
    bitonic_merge16_desc(L);
}

__global__ void __launch_bounds__(NWAVES * 64, 2) fwd_mega(Args args) {
    extern __shared__ __attribute__((aligned(16))) unsigned char lds[];
    Frame F;
    F.lds = (LAS unsigned char*)lds;
    F.MISC = (volatile LAS unsigned*)(F.lds + MISC_OFF);
    F.tid = threadIdx.x; F.lane = F.tid & 63; F.wave = __builtin_amdgcn_readfirstlane(F.tid >> 6);
    F.G = gridDim.x; { const int bx = blockIdx.x; F.vcu = (F.G % 8 == 0) ? (bx % 8) * (F.G / 8) + bx / 8 : bx; }
    unsigned char* ws = args.ws;
    F.ctl = (gu32*)(ws + WS_CTL);
    const float* x = args.in[0]; const float* ln_emb_g = args.in[1]; const float* ln_emb_b = args.in[2]; const float* w_in = args.in[3];
    const float* dil_norm_g = args.in[4]; const float* lq1 = args.in[5]; const float* lk1 = args.in[6]; const float* lq2 = args.in[7]; const float* lk2 = args.in[8];
    const float* subln_g = args.in[9]; const float* w_out = args.in[10]; const float* ln1_g = args.in[11]; const float* ln1_b = args.in[12];
    const float* w_query = args.in[13]; const float* sub_keys = args.in[14]; const float* peer_u = args.in[15]; const float* peer_v = args.in[16];
    const float* ln2_g = args.in[17]; const float* ln2_b = args.in[18];
    float* out = args.out;
    bf16* KEYS = (bf16*)(ws + WS_KEYS); float* ROPEA = (float*)(ws + WS_ROPEA); float* ROPED = (float*)(ws + WS_ROPED); float* LSE = (float*)(ws + WS_LSE);
    unsigned char* WOUT = ws + WS_WOUT; unsigned char* WQ = ws + WS_WQ; float* CM = (float*)(ws + WS_CM); unsigned char* WIN = ws + WS_WIN; unsigned char* XN8 = ws + WS_XN8;
    float* SA0 = (float*)(ws + WS_SA0); float* SA1 = (float*)(ws + WS_SA1); float* SWI = (float*)(ws + WS_SWI); float* SWO = (float*)(ws + WS_SWO);
    bf16* XN = (bf16*)(ws + WS_XN); bf16* QA = (bf16*)(ws + WS_QA); bf16* KA = (bf16*)(ws + WS_KA); bf16* VA = (bf16*)(ws + WS_VA);
    bf16* QD = (bf16*)(ws + WS_QD); bf16* KD = (bf16*)(ws + WS_KD); bf16* VD = (bf16*)(ws + WS_VD);
    bf16* OC = (bf16*)(ws + WS_OC); bf16* OD = (bf16*)(ws + WS_OD); unsigned char* MIXED = ws + WS_MIXED; bf16* PRE = (bf16*)(ws + WS_PRE);
    bf16* H1 = (bf16*)(ws + WS_H1); bf16* QP = (bf16*)(ws + WS_QP); unsigned char* U8 = ws + WS_U8; unsigned char* V8 = ws + WS_V8; float* SC2 = (float*)(ws + WS_USC); float* SX = (float*)(ws + WS_SX); unsigned char* X8 = ws + WS_X8;
    float* ZP = (float*)(ws + WS_ZP); float* AX = (float*)(ws + WS_A); bf16* YV = (bf16*)(ws + WS_Y);
    unsigned short* IDX = (unsigned short*)(ws + WS_IDX); float* GATE = (float*)(ws + WS_G);

    for (int u = F.tid; u < (LDS_BYTES - LDSCTL_OFF) / 4; u += NWAVES * 64) ((LAS unsigned*)(F.lds + LDSCTL_OFF))[u] = 0u;
    __syncthreads();
    XcdBarrier bar; bar.bar = (unsigned*)(F.ctl + CW_BAR); bar.x = 0; bar.st = nullptr;
    if (N_LAUNCHES == 1) bar = xcd_barrier_post((unsigned*)(F.ctl + CW_BAR), F.MISC + 8);
#define GRID_BAR() do { if (N_LAUNCHES == 1) xcd_barrier(bar); } while (0)
    const int lo = args.ph_lo, hi = args.ph_hi;
#define IN(k) (lo <= (k) && (k) < hi)
#define BOTH(k) (IN(k) && IN((k) + 1))
    const int gw = F.vcu * NWAVES + F.wave, NGW = F.G * NWAVES;
    const int lane = F.lane;

    if (IN(0)) {
        LAS float* scr = (LAS float*)(F.lds + RING_OFF + F.wave * 16384);
        for (int it = F.vcu; it < INW / 32 + DMODEL / 32; it += F.G) {
            if (it < INW / 32) p0_quant_item(w_in, INW, 32 * it, WIN, SWI, F.lds + RING_OFF, F.tid);
            else p0_quant_item(w_out, DMODEL, 32 * (it - INW / 32), WOUT, SWO, F.lds + RING_OFF, F.tid);
        }
        constexpr int I_SQ = (DMODEL / 64) * (DMODEL / 32);
        for (int it = gw; it < I_SQ; it += NGW) p0_colmax_item(w_query, DMODEL, (int*)CM, it, lane);
        cvt_chunks(sub_keys, KEYS, (size_t)(8 * 2 * 128 * 128) / 512, gw, NGW, lane);
        for (int e = gw * 64 + lane; e < 4096 * 16 + 4096 * 8; e += NGW * 64) {
            int pos, i, half; float* dst;
            if (e < 4096 * 16) { pos = e >> 4; i = e & 15; half = 16; dst = ROPEA + pos * 32; }
            else { const int e2 = e - 4096 * 16; pos = e2 >> 3; i = e2 & 7; half = 8; dst = ROPED + pos * 16; }
            const float inv_freq = __builtin_amdgcn_exp2f(-(float)i / (float)half * 18.931568569324174f);
            const float ang = (float)pos * inv_freq;
            const double rev = (double)ang * 0.15915494309189535; const float fr = (float)(rev - floor(rev));
            dst[i] = __builtin_amdgcn_cosf(fr); dst[half + i] = __builtin_amdgcn_sinf(fr);
        }
        { f32x4 cur[8], nxt[8];
          if (gw < M) ln_row_load(lane, x + (size_t)gw * DMODEL, nxt);
          for (int m = gw; m < M; m += NGW) {
#pragma unroll
              for (int j = 0; j < 8; ++j) cur[j] = nxt[j];
              if (m + NGW < M) ln_row_load(lane, x + (size_t)(m + NGW) * DMODEL, nxt);
              ln_row_to_bf16(lane, cur, ln_emb_g, ln_emb_b, XN + (size_t)m * DMODEL, XN8 + (size_t)m * DMODEL, SA0 + m); } }
        if (BOTH(0)) GRID_BAR();
    }

    if (IN(1)) {
        pg8::Gemm g{XN8, WIN, M, INW, DMODEL}; pg8::StaticOrder S; S.init(M, INW, F.G, (int)blockIdx.x);
        pg8::EpiQKV E{QA, KA, VA, QD, KD, VD, ROPEA, ROPED, 0.125f * 1.4426950408889634f, SA0, SWI};
        pg8::gemm_phase<pg8::EpiQKV, pg8::StaticOrder, true, true>(F.lds + RING_OFF, g, S, E);
        if (BOTH(1)) GRID_BAR();
    }

    if (IN(2)) {
        {
            for (int U = F.vcu; U < 512; U += F.G) {
                const int combo = U >> 4, qb = U & 15;
                const int b = combo >> 3, h = (combo >> 1) & 3, map = combo & 1;
                attn_body::attn_unit<8>(b, (2 * h + map) * 64, h * 128, qb, (const attn_body::bf16*)QD, (const attn_body::bf16*)KD, (const attn_body::bf16*)VD,
                                        (attn_body::bf16*)(OD + (size_t)map * M * 512), (char*)lds + RING_OFF);
            }
        }
        __syncthreads();
        {
            using BR = dil::BlockRef<dil::bf16, dil::bf16>;
            const int total = 48 * 48;
            int L = F.vcu;
            if (L < total) {
                BR cur = dil_ref(L, QA, KA, VA, OC, LSE);
                dil::Seam<dil::bf16> Sm;
                dil::causal_swa_prime<dil::bf16, dil::bf16>(cur, 0, (char*)lds + RING_OFF, Sm);
                for (;;) {
                    const bool more = L + F.G < total;
                    const BR nxt = more ? dil_ref(L + F.G, QA, KA, VA, OC, LSE) : cur;
                    dil::causal_swa_block<dil::bf16, dil::bf16>(cur, nxt, 0, (char*)lds + RING_OFF, Sm);
                    if (!more) break;
                    cur = nxt; L += F.G;
                }
            }
        }
        if (BOTH(2)) GRID_BAR();
    }

    if (IN(3)) {
        const int lane = lane_id_fresh();
        float lam;
        { const float a1 = wave_sum(lq1[lane] * lk1[lane]), a2 = wave_sum(lq2[lane] * lk2[lane]); lam = __expf(a1) - __expf(a2) + LAM_INIT; }
        const int hl = lane >> 4, d0 = (lane & 15) * 8;
        f32x4 ga0 = *(const f32x4*)(dil_norm_g + d0), ga1 = *(const f32x4*)(dil_norm_g + d0 + 4);
        f32x4 gb0 = *(const f32x4*)(subln_g + d0) * (1.f - LAM_INIT), gb1 = *(const f32x4*)(subln_g + d0 + 4) * (1.f - LAM_INIT);
        for (int t = gw; t < M; t += NGW) {
            float r[4][8]; float mx = 0.f;
#pragma unroll
            for (int hg = 0; hg < 4; ++hg) {
                float o[8];
                if (hg < 3) {
                    const int head = hg * 4 + hl;
                    const float l0 = LSE[(size_t)t * 12 + head], l1 = LSE[(size_t)M * 12 + (size_t)t * 12 + head], l2 = LSE[(size_t)2 * M * 12 + (size_t)t * 12 + head];
                    const float mxl = fmaxf(l0, fmaxf(l1, l2)); float w0 = __expf(l0 - mxl), w1 = __expf(l1 - mxl), w2 = __expf(l2 - mxl);
                    const float inv = 1.f / (w0 + w1 + w2); w0 *= inv; w1 *= inv; w2 *= inv;
                    const size_t off = (size_t)t * 1536 + head * 128 + d0;
                    const v4u a = __builtin_nontemporal_load((const GAS v4u*)(OC + off)), b = __builtin_nontemporal_load((const GAS v4u*)(OC + (size_t)M * 1536 + off)), c = __builtin_nontemporal_load((const GAS v4u*)(OC + (size_t)2 * M * 1536 + off));
#pragma unroll
                    for (int k = 0; k < 4; ++k) { o[2 * k] = w0 * bflo(a[k]) + w1 * bflo(b[k]) + w2 * bflo(c[k]); o[2 * k + 1] = w0 * bfhi(a[k]) + w1 * bfhi(b[k]) + w2 * bfhi(c[k]); }
                } else {
                    const size_t off = (size_t)t * 512 + hl * 128 + d0;
                    const v4u a = __builtin_nontemporal_load((const GAS v4u*)(OD + off)), b = __builtin_nontemporal_load((const GAS v4u*)(OD + (size_t)M * 512 + off));
#pragma unroll
                    for (int k = 0; k < 4; ++k) { o[2 * k] = bflo(a[k]) - lam * bflo(b[k]); o[2 * k + 1] = bfhi(a[k]) - lam * bfhi(b[k]); }
                }
                float ss = 0.f;
#pragma unroll
                for (int k = 0; k < 8; ++k) ss += o[k] * o[k];
                ss += __shfl_xor(ss, 1); ss += __shfl_xor(ss, 2); ss += __shfl_xor(ss, 4); ss += __shfl_xor(ss, 8);
                const float rinv = 1.f / sqrtf(ss * (1.f / 128.f) + LN_EPS);
                const f32x4 g0 = hg < 3 ? ga0 : gb0, g1 = hg < 3 ? ga1 : gb1;
                r[hg][0] = o[0] * rinv * g0.x; r[hg][1] = o[1] * rinv * g0.y; r[hg][2] = o[2] * rinv * g0.z; r[hg][3] = o[3] * rinv * g0.w;
                r[hg][4] = o[4] * rinv * g1.x; r[hg][5] = o[5] * rinv * g1.y; r[hg][6] = o[6] * rinv * g1.z; r[hg][7] = o[7] * rinv * g1.w;
#pragma unroll
                for (int k = 0; k < 8; ++k) mx = fmaxf(mx, fabsf(r[hg][k]));
            }
#pragma unroll
            for (int o = 1; o < 64; o <<= 1) mx = fmaxf(mx, __shfl_xor(mx, o));
            const float qs = mx > 0.f ? 127.f / mx : 1.f;
            if (lane == 0) SA1[t] = mx > 0.f ? mx * (1.f / 127.f) : 1.f;
#pragma unroll
            for (int hg = 0; hg < 4; ++hg) { unsigned w[2];
#pragma unroll
                for (int k = 0; k < 2; ++k) { const int a0 = (int)rintf(r[hg][4 * k] * qs), a1 = (int)rintf(r[hg][4 * k + 1] * qs), a2 = (int)rintf(r[hg][4 * k + 2] * qs), a3 = (int)rintf(r[hg][4 * k + 3] * qs);
                    w[k] = (unsigned)(a0 & 255) | ((unsigned)(a1 & 255) << 8) | ((unsigned)(a2 & 255) << 16) | ((unsigned)(a3 & 255) << 24); }
                *(GAS unsigned long long*)(MIXED + (size_t)t * 2048 + hg * 512 + hl * 128 + d0) = (unsigned long long)w[0] | ((unsigned long long)w[1] << 32); }
        }
        if (BOTH(3)) GRID_BAR();
    }

    if (IN(4)) {
        pg8::Gemm g{MIXED, WOUT, M, DMODEL, DMODEL}; pg8::StaticOrder S; S.init(M, DMODEL, F.G, (int)blockIdx.x);
        pg8::EpiPre E{XN, PRE, ALPHA, SA1, SWO};
        pg8::gemm_phase<pg8::EpiPre, pg8::StaticOrder, true, true>(F.lds + RING_OFF, g, S, E);
        if (BOTH(4)) GRID_BAR();
    }

    if (IN(5)) {
        const int lane = lane_id_fresh();
        for (int it = gw; it < 32 * 64; it += NGW) wq_quant_item(w_query, CM, WQ, F.lds + RING_OFF + F.wave * 4608, it, lane);
        f32x4 nxt5[8];
        if (gw < M) ln_row_load_bf16(lane, PRE + (size_t)gw * DMODEL, nxt5);
        for (int m = gw; m < M; m += NGW) {
            f32x4 v[8]; float s = 0.f;
#pragma unroll
            for (int j = 0; j < 8; ++j) v[j] = nxt5[j];
            if (m + NGW < M) ln_row_load_bf16(lane, PRE + (size_t)(m + NGW) * DMODEL, nxt5);
#pragma unroll
            for (int j = 0; j < 8; ++j) s += (v[j].x + v[j].y) + (v[j].z + v[j].w);
            const float mean = wave_sum(s) * (1.f / DMODEL); float s2 = 0.f;
#pragma unroll
            for (int j = 0; j < 8; ++j) { v[j] = v[j] - mean; s2 += (v[j].x * v[j].x + v[j].y * v[j].y) + (v[j].z * v[j].z + v[j].w * v[j].w); }
            const float rstd = 1.f / sqrtf(wave_sum(s2) * (1.f / DMODEL) + LN_EPS);
            GAS unsigned long long* o8 = (GAS unsigned long long*)(H1 + (size_t)m * DMODEL) + lane;
            const GAS f32x4* gr = (const GAS f32x4*)ln1_g + lane; const GAS f32x4* br = (const GAS f32x4*)ln1_b + lane;
            float mx = 0.f;
#pragma unroll
            for (int j = 0; j < 8; ++j) { const f32x4 gg = gr[64 * j], bb = br[64 * j]; v[j] = v[j] * rstd * gg + bb;
                o8[64 * j] = (unsigned long long)pk2(v[j].x, v[j].y) | ((unsigned long long)pk2(v[j].z, v[j].w) << 32);
                mx = fmaxf(mx, fmaxf(fmaxf(fabsf(v[j].x), fabsf(v[j].y)), fmaxf(fabsf(v[j].z), fabsf(v[j].w)))); }
#pragma unroll
            for (int o = 1; o < 64; o <<= 1) mx = fmaxf(mx, __shfl_xor(mx, o));
            const float qs = mx > 0.f ? 127.f / mx : 1.f;
            if (lane == 0) SX[m] = mx > 0.f ? mx * (1.f / 127.f) : 1.f;
            GAS unsigned* x8 = (GAS unsigned*)(X8 + (size_t)m * DMODEL) + lane;
#pragma unroll
            for (int j = 0; j < 8; ++j) { const int a0 = (int)rintf(v[j].x * qs), a1 = (int)rintf(v[j].y * qs), a2 = (int)rintf(v[j].z * qs), a3 = (int)rintf(v[j].w * qs);
                x8[64 * j] = (unsigned)(a0 & 255) | ((unsigned)(a1 & 255) << 8) | ((unsigned)(a2 & 255) << 16) | ((unsigned)(a3 & 255) << 24); }
        }
        if (BOTH(5)) GRID_BAR();
    }

    if (IN(6)) {
        pg8::Gemm g{X8, WQ, M, DMODEL, DMODEL}; pg8::StaticOrder S; S.init(M, DMODEL, F.G, (int)blockIdx.x);
        pg8::EpiQP E{QP, SX, CM};
        pg8::gemm_phase<pg8::EpiQP, pg8::StaticOrder, true, true>(F.lds + RING_OFF, g, S, E);
        if (BOTH(6)) GRID_BAR();
    }

    if (IN(7)) {
        typedef float f32x16 __attribute__((ext_vector_type(16)));
        const int lane = lane_id_fresh();
        const int r32 = lane & 31, hi5 = lane >> 5;
        LAS unsigned char* kst = F.lds + RING_OFF + F.wave * 8704;
        for (int step = 0; step < 2; ++step) {
        const bool conv = (step == 0);
        if (conv) {
            for (int row0 = gw; row0 < 2 * NEXP; row0 += 2 * NGW) {
                f32x4 v[2][8];
#pragma unroll
                for (int rr = 0; rr < 2; ++rr) { const int row = row0 + rr * NGW; if (row < 2 * NEXP) {
                    const bool isv = row >= NEXP; const int e = isv ? row - NEXP : row;
                    const GAS f32x4* src = (const GAS f32x4*)((isv ? peer_v : peer_u) + (size_t)e * DMODEL) + lane;
#pragma unroll
                    for (int q = 0; q < 8; ++q) v[rr][q] = __builtin_nontemporal_load(src + 64 * q); } }
#pragma unroll
                for (int rr = 0; rr < 2; ++rr) { const int row = row0 + rr * NGW; if (row < 2 * NEXP) {
                    const bool isv = row >= NEXP; const int e = isv ? row - NEXP : row;
                    float m_ = 0.f;
#pragma unroll
                    for (int q = 0; q < 8; ++q) m_ = fmaxf(m_, fmaxf(fmaxf(fabsf(v[rr][q].x), fabsf(v[rr][q].y)), fmaxf(fabsf(v[rr][q].z), fabsf(v[rr][q].w))));
#pragma unroll
                    for (int o = 1; o < 64; o <<= 1) m_ = fmaxf(m_, __shfl_xor(m_, o));
                    const float qmax = isv ? 256.f : 127.f;
                    const float sc = m_ > 0.f ? qmax / m_ : 1.f;
                    if (lane == 0) SC2[2 * e + (isv ? 1 : 0)] = m_ > 0.f ? m_ / qmax : 1.f;
                    unsigned char* dst = (isv ? V8 : U8) + (size_t)(lane >> 5) * (NEXP * 128) + (size_t)e * 128 + 4 * (lane & 31);
#pragma unroll
                    for (int q = 0; q < 8; ++q) { const f32x4 a = v[rr][q] * sc; int p = 0;
                        if (isv) { p = __builtin_amdgcn_cvt_pk_fp8_f32(a.x, a.y, p, false); p = __builtin_amdgcn_cvt_pk_fp8_f32(a.z, a.w, p, true); }
                        else { p = (int)(((unsigned)((int)rintf(a.x) & 255)) | ((unsigned)((int)rintf(a.y) & 255) << 8) | ((unsigned)((int)rintf(a.z) & 255) << 16) | ((unsigned)((int)rintf(a.w) & 255) << 24)); }
                        *(GAS unsigned*)(dst + (size_t)(2 * q) * (NEXP * 128)) = (unsigned)p; } } }
            }
        } else {
        for (int job = gw; job < (M / 32) * 8; job += NGW) {
            const int h = job & 7, tok0 = (job >> 3) * 32;
            int la[16], lb[16];
#pragma unroll
            for (int c = 0; c < 2; ++c) {
                int L[16];
                bf16x8 bq[8];
                { const bf16* qs_ = QP + (size_t)tok0 * 2048 + h * 256 + c * 128; v4u qv[8];
#pragma unroll
                  for (int i = 0; i < 8; ++i) qv[i] = __builtin_nontemporal_load((const GAS v4u*)(qs_ + (size_t)(i * 4 + (lane >> 4)) * 2048 + (lane & 15) * 8));
#pragma unroll
                  for (int i = 0; i < 8; ++i) *(LAS v4u*)(kst + (i * 4 + (lane >> 4)) * 272 + (lane & 15) * 16) = qv[i]; }
#pragma unroll
                for (int ks = 0; ks < 8; ++ks) bq[ks] = *(const LAS bf16x8*)(kst + r32 * 272 + ks * 32 + hi5 * 16);
#pragma unroll
                for (int i = 0; i < 16; ++i) L[i] = (int)0x80000000;
#pragma unroll 1
                for (int mt = 0; mt < 4; ++mt) {
                    f32x16 acc = {};
                    { const bf16* ks_ = KEYS + (size_t)((h * 2 + c) * 128 + mt * 32) * 128; v4u kv[8];
#pragma unroll
                      for (int i = 0; i < 8; ++i) kv[i] = *(const GAS v4u*)(ks_ + (size_t)(i * 4 + (lane >> 4)) * 128 + (lane & 15) * 8);
#pragma unroll
                      for (int i = 0; i < 8; ++i) *(LAS v4u*)(kst + (i * 4 + (lane >> 4)) * 272 + (lane & 15) * 16) = kv[i]; }
#pragma unroll
                    for (int ks = 0; ks < 8; ++ks) { const bf16x8 af = *(const LAS bf16x8*)(kst + r32 * 272 + ks * 32 + hi5 * 16); acc = __builtin_amdgcn_mfma_f32_32x32x16_bf16(af, bq[ks], acc, 0, 0, 0); }
                    int B[16];
#pragma unroll
                    for (int r = 0; r < 16; ++r) { const int key = mt * 32 + (r & 3) + 8 * (r >> 2) + 4 * hi5; B[r] = (fkey(acc[r]) & ~127) | key; }
                    bitonic_sort16_desc(B);
                    top16_merge(L, B);
                }
                { int P[16];
#pragma unroll
                for (int i = 0; i < 16; ++i) P[i] = __shfl_xor(L[i], 32);
                top16_merge(L, P); }
#pragma unroll
                for (int i = 0; i < 16; ++i) { if (c == 0) la[i] = L[i]; else lb[i] = L[i]; }
            }
            float fa[16], fb[16];
#pragma unroll
            for (int i = 0; i < 16; ++i) { fa[i] = keyf(la[i] & ~127); fb[i] = keyf(lb[i] & ~127); }
            int C[16];
#pragma unroll
            for (int j = 0; j < 16; ++j) C[j] = (fkey(fa[0] + fb[j]) & ~255) | j;
#define CANDKEY(i_, j_) ((fkey(fa[i_] + fb[j_]) & ~255) | ((i_) << 4) | (j_))
            { int B[16];
              B[0] = CANDKEY(1, 0);
              B[1] = CANDKEY(1, 1);
              B[2] = CANDKEY(1, 2);
              B[3] = CANDKEY(1, 3);
              B[4] = CANDKEY(1, 4);
              B[5] = CANDKEY(1, 5);
              B[6] = CANDKEY(1, 6);
              B[7] = CANDKEY(1, 7);
              B[8] = CANDKEY(2, 0);
              B[9] = CANDKEY(2, 1);
              B[10] = CANDKEY(2, 2);
              B[11] = CANDKEY(2, 3);
              B[12] = CANDKEY(2, 4);
              B[13] = CANDKEY(3, 0);
              B[14] = CANDKEY(3, 1);
              B[15] = CANDKEY(3, 2);
              bitonic_sort16_desc(B); top16_merge(C, B); }
            { int B[16];
              B[0] = CANDKEY(3, 3);
              B[1] = CANDKEY(4, 0);
              B[2] = CANDKEY(4, 1);
              B[3] = CANDKEY(4, 2);
              B[4] = CANDKEY(5, 0);
              B[5] = CANDKEY(5, 1);
              B[6] = CANDKEY(6, 0);
              B[7] = CANDKEY(6, 1);
              B[8] = CANDKEY(7, 0);
              B[9] = CANDKEY(7, 1);
              B[10] = CANDKEY(8, 0);
              B[11] = CANDKEY(9, 0);
              B[12] = CANDKEY(10, 0);
              B[13] = CANDKEY(11, 0);
              B[14] = CANDKEY(12, 0);
              B[15] = CANDKEY(13, 0);
              bitonic_sort16_desc(B); top16_merge(C, B); }
            { int B[16];
              B[0] = CANDKEY(14, 0);
              B[1] = CANDKEY(15, 0);
              B[2] = (int)0x80000000;
              B[3] = (int)0x80000000;
              B[4] = (int)0x80000000;
              B[5] = (int)0x80000000;
              B[6] = (int)0x80000000;
              B[7] = (int)0x80000000;
              B[8] = (int)0x80000000;
              B[9] = (int)0x80000000;
              B[10] = (int)0x80000000;
              B[11] = (int)0x80000000;
              B[12] = (int)0x80000000;
              B[13] = (int)0x80000000;
              B[14] = (int)0x80000000;
              B[15] = (int)0x80000000;
              bitonic_sort16_desc(B); top16_merge(C, B); }
#undef CANDKEY
            LAS unsigned char* tab = (LAS unsigned char*)(F.lds + RING_OFF + 8 * 8704) + (F.wave * 64 + lane) * 36;
#pragma unroll
            for (int i = 0; i < 4; ++i) { ((LAS unsigned*)tab)[i] = (unsigned)(la[4 * i] & 127) | ((unsigned)(la[4 * i + 1] & 127) << 8) | ((unsigned)(la[4 * i + 2] & 127) << 16) | ((unsigned)(la[4 * i + 3] & 127) << 24);
                                          ((LAS unsigned*)tab)[4 + i] = (unsigned)(lb[4 * i] & 127) | ((unsigned)(lb[4 * i + 1] & 127) << 8) | ((unsigned)(lb[4 * i + 2] & 127) << 16) | ((unsigned)(lb[4 * i + 3] & 127) << 24); }
            int ex[16];
#pragma unroll
            for (int k = 0; k < 16; ++k) { const int ci = (C[k] >> 4) & 15, cj = C[k] & 15; ex[k] = (int)tab[ci] * 128 + (int)tab[16 + cj]; }
            const float s0 = keyf(C[0] & ~255); float e[16]; float den = 0.f;
#pragma unroll
            for (int k = 0; k < 16; ++k) { e[k] = __expf(keyf(C[k] & ~255) - s0); den += e[k]; }
            const float rden = 1.f / den;
            if (hi5 == 0) {
                unsigned short* ip = IDX + (size_t)(tok0 + r32) * 128 + h * 16; float* gp = GATE + (size_t)(tok0 + r32) * 128 + h * 16;
                v4u i0_, i1_;
                i0_.x = (unsigned)ex[0] | ((unsigned)ex[1] << 16); i0_.y = (unsigned)ex[2] | ((unsigned)ex[3] << 16); i0_.z = (unsigned)ex[4] | ((unsigned)ex[5] << 16); i0_.w = (unsigned)ex[6] | ((unsigned)ex[7] << 16);
                i1_.x = (unsigned)ex[8] | ((unsigned)ex[9] << 16); i1_.y = (unsigned)ex[10] | ((unsigned)ex[11] << 16); i1_.z = (unsigned)ex[12] | ((unsigned)ex[13] << 16); i1_.w = (unsigned)ex[14] | ((unsigned)ex[15] << 16);
                *(GAS v4u*)ip = i0_; *(GAS v4u*)(ip + 8) = i1_;
#pragma unroll
                for (int k = 0; k < 16; k += 4) *(f32x4*)(gp + k) = (f32x4){e[k] * rden, e[k + 1] * rden, e[k + 2] * rden, e[k + 3] * rden};
            }
        }
        }
        }
        if (BOTH(7)) GRID_BAR();
    }

    if (IN(8)) {
        const int lane = lane_id_fresh();
        const int g = lane >> 3, c = lane & 7, b0 = c & 1, b1 = (c >> 1) & 1, b2 = (c >> 2) & 1;
        const int label = blockIdx.x & 7, member = blockIdx.x >> 3, nmem = (F.G + 7 - label) >> 3, st = nmem * 8;
        const int i0 = 8 * b2 + 4 * b0 + 2 * b1;
#define PU_IDX(T) do { const GAS v4u* ip_ = (const GAS v4u*)(IDX + (unsigned)((T) * 128 + 16 * g)); _Pragma("unroll") for (int i = 0; i < 2; ++i) { const v4u v_ = ip_[i]; _Pragma("unroll") for (int q = 0; q < 4; ++q) { en[8 * i + 2 * q] = (int)(v_[q] & 0xffffu); en[8 * i + 2 * q + 1] = (int)(v_[q] >> 16); } } } while (0)
#define PU_ROWS(BUF, XA, XB, T) do { _Pragma("unroll") for (int i = 0; i < 16; ++i) BUF[i] = *(const GAS v4u*)(U8s + (unsigned)(en[i] * 128)); \
            XA = __builtin_nontemporal_load((const GAS v4u*)(X8 + (unsigned)((T) * 2048 + soff))); } while (0)
#define PU_COMP(BUF, XA, XB, T) do { \
            float pz[16]; \
            _Pragma("unroll") for (int i = 0; i < 16; ++i) { int acc = 0; \
                _Pragma("unroll") for (int q = 0; q < 4; ++q) acc = __builtin_amdgcn_sdot4((int)BUF[i][q], (int)XA[q], acc, false); \
                pz[i] = (float)acc; } \
            float q8[8], q4[4], q2[2]; \
            _Pragma("unroll") for (int j = 0; j < 8; ++j) { const float keep = b2 ? pz[j + 8] : pz[j], send = b2 ? pz[j] : pz[j + 8]; q8[j] = keep + dpp_f<0x141>(send); } \
            _Pragma("unroll") for (int j = 0; j < 4; ++j) { const float keep = b0 ? q8[j + 4] : q8[j], send = b0 ? q8[j] : q8[j + 4]; q4[j] = keep + dpp_f<0xB1>(send); } \
            _Pragma("unroll") for (int j = 0; j < 2; ++j) { const float keep = b1 ? q4[j + 2] : q4[j], send = b1 ? q4[j] : q4[j + 2]; q2[j] = keep + dpp_f<0x4E>(send); } \
            __builtin_nontemporal_store((f32x2){q2[0], q2[1]}, (GAS f32x2*)(ZP + ((size_t)s * M + (T)) * 128 + 16 * g + i0)); } while (0)
        for (int p = 0; p < 2; ++p) {
            const int s = label * 2 + p; const int soff = 128 * s + 16 * c;
            const unsigned char* U8s = U8 + (size_t)s * (NEXP * 128) + 16 * c;
            int t = member * 8 + F.wave;
            int en[16]; v4u bA[16], bB[16]; v4u xA0, xA1, xB0, xB1;
            if (t < M) { PU_IDX(t); PU_ROWS(bA, xA0, xA1, t); if (t + st < M) PU_IDX(t + st); }
            for (; t < M; t += 2 * st) {
                if (t + st < M) { PU_ROWS(bB, xB0, xB1, t + st); if (t + 2 * st < M) PU_IDX(t + 2 * st); }
                PU_COMP(bA, xA0, xA1, t);
                if (t + st < M) {
                    if (t + 2 * st < M) { PU_ROWS(bA, xA0, xA1, t + 2 * st); if (t + 3 * st < M) PU_IDX(t + 3 * st); }
                    PU_COMP(bB, xB0, xB1, t + st);
                }
            }
        }
#undef PU_ROWS
#undef PU_COMP
        if (BOTH(8)) GRID_BAR();
    }
    if (IN(9)) {
        for (size_t i = ((size_t)blockIdx.x * 512 + F.tid) * 4; i < (size_t)M * 128; i += (size_t)F.G * 512 * 4) {
            f32x4 z = {0.f, 0.f, 0.f, 0.f};
#pragma unroll
            for (int s = 0; s < 16; ++s) z = z + __builtin_nontemporal_load((const GAS f32x4*)(ZP + (size_t)s * M * 128 + i));
            const uint2 e2_ = *(const uint2*)(IDX + i); const v4u e = {e2_.x & 0xffffu, e2_.x >> 16, e2_.y & 0xffffu, e2_.y >> 16}; const f32x4 gt = *(const GAS f32x4*)(GATE + i); const float sx = SX[i >> 7];
            f32x4 a;
            const f32x2 s0_ = *(const GAS f32x2*)(SC2 + 2 * e.x), s1_ = *(const GAS f32x2*)(SC2 + 2 * e.y), s2_ = *(const GAS f32x2*)(SC2 + 2 * e.z), s3_ = *(const GAS f32x2*)(SC2 + 2 * e.w);
            a.x = gt.x * gelu_erf(z.x * s0_.x * sx) * s0_.y; a.y = gt.y * gelu_erf(z.y * s1_.x * sx) * s1_.y;
            a.z = gt.z * gelu_erf(z.z * s2_.x * sx) * s2_.y; a.w = gt.w * gelu_erf(z.w * s3_.x * sx) * s3_.y;
            *(GAS f32x4*)(AX + i) = a;
        }
        if (BOTH(9)) GRID_BAR();
    }
    if (IN(10)) {
        const int lane = lane_id_fresh();
        const int g = lane >> 3, c = lane & 7, b3 = g & 1, b4 = (g >> 1) & 1, b5 = (g >> 2) & 1;
        const int label = blockIdx.x & 7, member = blockIdx.x >> 3, nmem = (F.G + 7 - label) >> 3, st = nmem * 8;
        const int j0 = 8 * b5 + 4 * b4 + 2 * b3;
#define PV_ROWS(BUF, AA, HH, T) do { _Pragma("unroll") for (int i = 0; i < 16; ++i) BUF[i] = *(const GAS v4u*)(V8s + (unsigned)(en[i] * 128)); \
            const GAS f32x4* ap_ = (const GAS f32x4*)(AX + (unsigned)((T) * 128 + 16 * g)); _Pragma("unroll") for (int i = 0; i < 4; ++i) { const f32x4 v_ = ap_[i]; AA[4 * i] = v_.x; AA[4 * i + 1] = v_.y; AA[4 * i + 2] = v_.z; AA[4 * i + 3] = v_.w; } \
            HH = __builtin_nontemporal_load((const GAS unsigned*)(H1 + (unsigned)((T) * 2048 + soff + j0))); } while (0)
#define PV_COMP(BUF, AA, HH, T) do { f32x2 y2[8]; \
            _Pragma("unroll") for (int m = 0; m < 8; ++m) y2[m] = (f32x2){0.f, 0.f}; \
            _Pragma("unroll") for (int i = 0; i < 16; ++i) { const f32x2 a2 = {AA[i], AA[i]}; \
                _Pragma("unroll") for (int q = 0; q < 4; ++q) { const int w = (int)BUF[i][q]; const f32x2 lo = __builtin_amdgcn_cvt_pk_f32_fp8(w, false), hi = __builtin_amdgcn_cvt_pk_f32_fp8(w, true); \
                    y2[2 * q] = __builtin_elementwise_fma(lo, a2, y2[2 * q]); y2[2 * q + 1] = __builtin_elementwise_fma(hi, a2, y2[2 * q + 1]); } } \
            float y[16]; _Pragma("unroll") for (int m = 0; m < 8; ++m) { y[2 * m] = y2[m].x; y[2 * m + 1] = y2[m].y; } \
            float q8[8], q4[4], q2[2]; \
            _Pragma("unroll") for (int j = 0; j < 8; ++j) q8[j] = xchg32(y[j], y[j + 8]); \
            _Pragma("unroll") for (int j = 0; j < 4; ++j) q4[j] = xchg16(q8[j], q8[j + 4]); \
            _Pragma("unroll") for (int j = 0; j < 2; ++j) { const float keep = b3 ? q4[j + 2] : q4[j], send = b3 ? q4[j] : q4[j + 2]; q2[j] = keep + dpp_f<0x128>(send); } \
            __builtin_nontemporal_store(pk2(q2[0] + ALPHA * bflo(HH), q2[1] + ALPHA * bfhi(HH)), (GAS unsigned*)(YV + (unsigned)((T) * 2048 + soff + j0))); } while (0)
        for (int p = 0; p < 2; ++p) {
            const int s = label * 2 + p; const int soff = 128 * s + 16 * c;
            const unsigned char* V8s = V8 + (size_t)s * (NEXP * 128) + 16 * c;
            int t = member * 8 + F.wave;
            int en[16]; v4u bA[16], bB[16]; float aA[16], aB[16]; unsigned hA, hB;
            if (t < M) { PU_IDX(t); PV_ROWS(bA, aA, hA, t); if (t + st < M) PU_IDX(t + st); }
            for (; t < M; t += 2 * st) {
                if (t + st < M) { PV_ROWS(bB, aB, hB, t + st); if (t + 2 * st < M) PU_IDX(t + 2 * st); }
                PV_COMP(bA, aA, hA, t);
                if (t + st < M) {
                    if (t + 2 * st < M) { PV_ROWS(bA, aA, hA, t + 2 * st); if (t + 3 * st < M) PU_IDX(t + 3 * st); }
                    PV_COMP(bB, aB, hB, t + st);
                }
            }
        }
#undef PV_ROWS
#undef PV_COMP
#undef PU_IDX
        if (BOTH(10)) GRID_BAR();
    }
    if (IN(11)) {
        const int lane = lane_id_fresh();
        unsigned long long nx11[8];
        if (gw < M) { const GAS unsigned long long* hr = (const GAS unsigned long long*)(YV + (size_t)gw * 2048) + lane;
#pragma unroll
            for (int j = 0; j < 8; ++j) nx11[j] = __builtin_nontemporal_load(hr + 64 * j); }
        for (int m = gw; m < M; m += NGW) {
            unsigned long long hc[8];
#pragma unroll
            for (int j = 0; j < 8; ++j) hc[j] = nx11[j];
            if (m + NGW < M) { const GAS unsigned long long* hr = (const GAS unsigned long long*)(YV + (size_t)(m + NGW) * 2048) + lane;
#pragma unroll
                for (int j = 0; j < 8; ++j) nx11[j] = __builtin_nontemporal_load(hr + 64 * j); }
            f32x4 v[8]; float s = 0.f;
#pragma unroll
            for (int j = 0; j < 8; ++j) { const unsigned long long h = hc[j]; const unsigned hl = (unsigned)h, hh = (unsigned)(h >> 32);
                v[j] = (f32x4){bflo(hl), bfhi(hl), bflo(hh), bfhi(hh)}; s += (v[j].x + v[j].y) + (v[j].z + v[j].w); }
            const float mean = wave_sum(s) * (1.f / DMODEL); float s2 = 0.f;
#pragma unroll
            for (int j = 0; j < 8; ++j) { v[j] = v[j] - mean; s2 += (v[j].x * v[j].x + v[j].y * v[j].y) + (v[j].z * v[j].z + v[j].w * v[j].w); }
            const float rstd = 1.f / sqrtf(wave_sum(s2) * (1.f / DMODEL) + LN_EPS);
            const GAS f32x4* gr = (const GAS f32x4*)ln2_g + lane; const GAS f32x4* br = (const GAS f32x4*)ln2_b + lane;
            GAS f32x4* orow = (GAS f32x4*)(out + (size_t)m * 2048) + lane;
#pragma unroll
            for (int j = 0; j < 8; ++j) __builtin_nontemporal_store(v[j] * rstd * gr[64 * j] + br[64 * j], orow + 64 * j);
        }
    }
#undef IN
#undef BOTH
#undef GRID_BAR
}


extern "C" void kernel_launch(void* const* d_in, const int* in_sizes, int n_in, void* d_out, int out_size, void* d_ws, size_t ws_size, hipStream_t stream) {
    static int grid = 0;
    if (grid == 0) {
        if (n_in != 19 || in_sizes[0] != M * DMODEL || out_size != M * DMODEL || ws_size < WS_END) {
            fprintf(stderr, "kernel_launch: shape/workspace mismatch (n_in %d, in0 %d, out %d, ws %zu; need ws >= %zu); nothing launched\n", n_in, n_in > 0 ? in_sizes[0] : -1, out_size, ws_size, (size_t)WS_END); grid = -1; return; }
        int dev = 0, cus = 0, per_cu = 0;
        if (hipGetDevice(&dev) != hipSuccess || hipDeviceGetAttribute(&cus, hipDeviceAttributeMultiprocessorCount, dev) != hipSuccess) { fprintf(stderr, "kernel_launch: device query failed\n"); grid = -1; return; }
        if (hipFuncSetAttribute((const void*)fwd_mega, hipFuncAttributeMaxDynamicSharedMemorySize, LDS_BYTES) != hipSuccess) { fprintf(stderr, "kernel_launch: hipFuncSetAttribute failed\n"); grid = -1; return; }
        if (hipOccupancyMaxActiveBlocksPerMultiprocessor(&per_cu, (const void*)fwd_mega, NWAVES * 64, LDS_BYTES) != hipSuccess || per_cu < 1)
            fprintf(stderr, "kernel_launch: note: occupancy query reports %d workgroups per CU\n", per_cu);
        (void)hipGetLastError();
        grid = cus;
        if (grid != 256) fprintf(stderr, "kernel_launch: note: %d CUs (tuned for 256)\n", grid);
    }
    if (grid < 0) return;
    if (hipMemsetAsync((char*)d_ws + WS_CTL, 0, CTL_ZERO_BYTES, stream) != hipSuccess) { fprintf(stderr, "kernel_launch: memset failed\n"); return; }
    Args a{};
    for (int i = 0; i < 19; ++i) a.in[i] = (const float*)d_in[i];
    a.out = (float*)d_out; a.ws = (unsigned char*)d_ws;
    if (N_LAUNCHES == 1) { a.ph_lo = 0; a.ph_hi = MK_PHASE_HI; a.li = 0; hipLaunchKernelGGL(fwd_mega, dim3(grid), dim3(NWAVES * 64), LDS_BYTES, stream, a); }
    else { for (int li = 0; li < MK_PHASE_HI; ++li) { a.ph_lo = li; a.ph_hi = li + 1; a.li = li; hipLaunchKernelGGL(fwd_mega, dim3(grid), dim3(NWAVES * 64), LDS_BYTES, stream, a);
        } }
    const hipError_t le = hipPeekAtLastError();
    if (le != hipSuccess) fprintf(stderr, "kernel_launch: launch failed: %s\n", hipGetErrorName(le));
}
```
